# Optimizing an MI355X kernel written in HIP

```python
import jax, jax.numpy as jnp
from jax import lax
import numpy as np

D_MODEL = 2048
BATCH = 4
SEQ = 8192
DEPTH = 1

ATTN_WIDTH = D_MODEL // 2
N_HEADS = 8
HEAD_DIM = ATTN_WIDTH // N_HEADS
MOBA_BLOCK = 256
MOBA_TOPK = 3
Q_CHUNK = 32
POOL_WIDTH = D_MODEL - ATTN_WIDTH
POOL_WINDOWS = (2, 4, 8, 16)
N_POOL_GROUPS = len(POOL_WINDOWS)
POOL_GROUP = POOL_WIDTH // N_POOL_GROUPS
MIX_WIDTH = ATTN_WIDTH + POOL_WIDTH
IN_WIDTH = 3 * ATTN_WIDTH + POOL_WIDTH
N_GROUPS = 8
EXPERTS_PER_GROUP = 8
N_EXPERTS = N_GROUPS * EXPERTS_PER_GROUP
TOPK_INNER = 2
D_EXPERT = D_MODEL // 4
DISPATCH_BLOCK = 128
PLE_DIM = 256
EPS = 1e-6

kernel_name = 'hymba_moba_pool_hmoe_ple'


def rms_norm(x, gain):
    xf = x.astype(jnp.float32)
    y = xf * lax.rsqrt(jnp.mean(xf * xf, axis=-1, keepdims=True) + EPS)
    return (y * gain.astype(jnp.float32)).astype(x.dtype)


def alibi_slopes(n):
    return jnp.asarray([2.0 ** (-8.0 * (h + 1) / n) for h in range(n)], jnp.float32)


def moba_attention(q, k, v):
    B, S = q.shape[0], q.shape[1]
    nb = -(-S // MOBA_BLOCK)
    pad = nb * MOBA_BLOCK - S
    K = min(MOBA_TOPK, nb)
    q = q.transpose(0, 2, 1, 3)
    k = jnp.pad(k.transpose(0, 2, 1, 3), ((0, 0), (0, 0), (0, pad), (0, 0)))
    v = jnp.pad(v.transpose(0, 2, 1, 3), ((0, 0), (0, 0), (0, pad), (0, 0)))
    kb = k.reshape(B, N_HEADS, nb, MOBA_BLOCK, HEAD_DIM)
    vb = v.reshape(B, N_HEADS, nb, MOBA_BLOCK, HEAD_DIM)
    kmean = jnp.mean(kb.astype(jnp.float32), axis=3).astype(k.dtype)
    slopes = alibi_slopes(N_HEADS)[None, :, None, None]
    scale = HEAD_DIM ** -0.5
    bi = jnp.arange(B)[:, None, None, None]
    hi = jnp.arange(N_HEADS)[None, :, None, None]
    blk_ids = jnp.arange(nb)
    in_blk = jnp.arange(MOBA_BLOCK)
    rank = jnp.arange(K)

    def chunk(c):
        start = c * Q_CHUNK
        own = start // MOBA_BLOCK
        qc = lax.dynamic_slice_in_dim(q, start, Q_CHUNK, axis=2)
        qpos = start + jnp.arange(Q_CHUNK)
        gate = jnp.einsum('bhqd,bhnd->bhqn', qc, kmean).astype(jnp.float32)
        gate = jnp.where(blk_ids < own, gate, -jnp.inf)
        _, sel = lax.top_k(gate, K)
        sel_ok = rank < own
        k_sel = kb[bi, hi, sel]
        v_sel = vb[bi, hi, sel]
        s_sel = jnp.einsum('bhqd,bhqnkd->bhqnk', qc, k_sel).astype(jnp.float32) * scale
        kpos_sel = sel[..., None] * MOBA_BLOCK + in_blk
        dist_sel = (qpos[:, None, None] - kpos_sel).astype(jnp.float32)
        s_sel = s_sel - slopes[..., None] * dist_sel
        s_sel = jnp.where(sel_ok[:, None], s_sel, -jnp.inf)
        k_own = lax.dynamic_index_in_dim(kb, own, axis=2, keepdims=False)
        v_own = lax.dynamic_index_in_dim(vb, own, axis=2, keepdims=False)
        s_own = jnp.einsum('bhqd,bhkd->bhqk', qc, k_own).astype(jnp.float32) * scale
        dist_own = qpos[:, None] - (own * MOBA_BLOCK + in_blk)[None, :]
        s_own = jnp.where(dist_own >= 0, s_own - slopes * dist_own.astype(jnp.float32), -jnp.inf)
        s = jnp.concatenate([s_sel.reshape(B, N_HEADS, Q_CHUNK, K * MOBA_BLOCK), s_own], axis=-1)
        prob = jax.nn.softmax(s, axis=-1).astype(v.dtype)
        p_sel = prob[..., :K * MOBA_BLOCK].reshape(B, N_HEADS, Q_CHUNK, K, MOBA_BLOCK)
        p_own = prob[..., K * MOBA_BLOCK:]
        return (jnp.einsum('bhqnk,bhqnkd->bhqd', p_sel, v_sel)
                + jnp.einsum('bhqk,bhkd->bhqd', p_own, v_own))

    outs = lax.map(chunk, jnp.arange(S // Q_CHUNK))
    return outs.transpose(1, 0, 3, 2, 4).reshape(B, S, N_HEADS * HEAD_DIM)


def pool_mixer(u, w_pool):
    B, S, _ = u.shape
    uf = u.astype(jnp.float32).reshape(B, S, N_POOL_GROUPS, POOL_GROUP)
    csum = jnp.concatenate([jnp.zeros_like(uf[:, :1]), jnp.cumsum(uf, axis=1)], axis=1)
    t = jnp.arange(S)[:, None]
    win = jnp.asarray(POOL_WINDOWS, jnp.int32)[None, :]
    lo = jnp.maximum(t + 1 - win, 0)
    gi = jnp.arange(N_POOL_GROUPS)[None, :]
    window_sum = csum[:, 1:] - csum[:, lo, gi]
    count = jnp.minimum(t + 1, win).astype(jnp.float32)
    z = window_sum / count[None, :, :, None] - uf
    z = jnp.einsum('bsgc,gcd->bsgd', z.astype(u.dtype), w_pool)
    return z.reshape(B, S, POOL_WIDTH)


def hier_moe(xn, w_rg, b_rg, w_re, b_re, w_gate, w_up, w_down):
    B, S, D = xn.shape
    T = B * S
    xt = xn.reshape(T, D)
    g_prob = jax.nn.softmax((xt @ w_rg).astype(jnp.float32) + b_rg.astype(jnp.float32), axis=-1)
    g_val, g_idx = lax.top_k(g_prob, 1)
    g_val, g_idx = g_val[:, 0], g_idx[:, 0]
    e_logits = jnp.einsum('td,gde->tge', xt, w_re).astype(jnp.float32) + b_re.astype(jnp.float32)
    e_logits = jnp.take_along_axis(e_logits, g_idx[:, None, None], axis=1)[:, 0]
    e_val, e_idx = lax.top_k(jax.nn.softmax(e_logits, axis=-1), TOPK_INNER)
    e_val = e_val / jnp.sum(e_val, axis=-1, keepdims=True)
    weights = g_val[:, None] * e_val
    eid = g_idx[:, None] * EXPERTS_PER_GROUP + e_idx
    N = T * TOPK_INNER
    M = DISPATCH_BLOCK
    flat_e = eid.reshape(N)
    flat_w = weights.reshape(N)
    flat_t = jnp.repeat(jnp.arange(T, dtype=jnp.int32), TOPK_INNER)
    order = jnp.argsort(flat_e)
    se, st, sw = flat_e[order], flat_t[order], flat_w[order]
    counts = jnp.bincount(flat_e, length=N_EXPERTS)
    starts = jnp.cumsum(counts) - counts
    padded = (counts + M - 1) // M * M
    pend = jnp.cumsum(padded)
    pstarts = pend - padded
    dest = pstarts[se] + (jnp.arange(N) - starts[se])
    P = N + N_EXPERTS * M
    nblk = P // M
    tok_buf = jnp.zeros((P,), jnp.int32).at[dest].set(st)
    w_buf = jnp.zeros((P,), jnp.float32).at[dest].set(sw)
    blk_e = jnp.clip(jnp.searchsorted(pend, jnp.arange(nblk) * M, side='right'), 0, N_EXPERTS - 1)

    def run(args):
        toks, wts, e = args
        xb = xt[toks]
        hid = jax.nn.silu(xb @ w_gate[e]) * (xb @ w_up[e])
        return (hid @ w_down[e]) * wts[:, None].astype(xb.dtype)

    yb = lax.map(run, (tok_buf.reshape(nblk, M), w_buf.reshape(nblk, M), blk_e))
    y = jax.ops.segment_sum(yb.reshape(P, D), tok_buf, num_segments=T)
    return y.reshape(B, S, D)


def setup_inputs(seed: int = 0) -> dict:
    key = jax.random.key(seed)
    ks = jax.random.split(key, 24)
    f32 = jnp.float32
    nrm = lambda k, shape, s: jax.random.normal(k, shape, f32) * s
    gain = lambda k, shape: 1.0 + 0.01 * jax.random.normal(k, shape, f32)
    L = DEPTH
    return {
        'x': nrm(ks[0], (BATCH, SEQ, D_MODEL), 1.0),
        'p': nrm(ks[1], (DEPTH, BATCH, SEQ, PLE_DIM), 1.0),
        'g_mix': gain(ks[2], (L, D_MODEL)),
        'w_in': nrm(ks[3], (L, D_MODEL, IN_WIDTH), D_MODEL ** -0.5),
        'beta_attn': gain(ks[4], (L, ATTN_WIDTH)),
        'w_pool': nrm(ks[5], (L, N_POOL_GROUPS, POOL_GROUP, POOL_GROUP), POOL_GROUP ** -0.5),
        'pool_scale': gain(ks[6], (L, POOL_WIDTH)),
        'w_out': nrm(ks[7], (L, MIX_WIDTH, D_MODEL), MIX_WIDTH ** -0.5),
        'g_ffn': gain(ks[8], (L, D_MODEL)),
        'w_router_group': nrm(ks[9], (L, D_MODEL, N_GROUPS), D_MODEL ** -0.5),
        'b_router_group': nrm(ks[10], (L, N_GROUPS), 0.01),
        'w_router_expert': nrm(ks[11], (L, N_GROUPS, D_MODEL, EXPERTS_PER_GROUP), D_MODEL ** -0.5),
        'b_router_expert': nrm(ks[12], (L, N_GROUPS, EXPERTS_PER_GROUP), 0.01),
        'w_expert_gate': nrm(ks[13], (L, N_EXPERTS, D_MODEL, D_EXPERT), D_MODEL ** -0.5),
        'w_expert_up': nrm(ks[14], (L, N_EXPERTS, D_MODEL, D_EXPERT), D_MODEL ** -0.5),
        'w_expert_down': nrm(ks[15], (L, N_EXPERTS, D_EXPERT, D_MODEL), D_EXPERT ** -0.5),
        'g_ple': gain(ks[16], (L, D_MODEL)),
        'w_ple': nrm(ks[17], (L, PLE_DIM, D_MODEL), PLE_DIM ** -0.5),
        'w_ple_gate': nrm(ks[18], (L, D_MODEL, D_MODEL), D_MODEL ** -0.5),
        'b_ple_gate': nrm(ks[19], (L, D_MODEL), 0.01),
        'g_final': gain(ks[20], (D_MODEL,)),
    }


def reference(x, p, g_mix, w_in, beta_attn, w_pool, pool_scale, w_out, g_ffn,
              w_router_group, b_router_group, w_router_expert, b_router_expert,
              w_expert_gate, w_expert_up, w_expert_down, g_ple, w_ple, w_ple_gate,
              b_ple_gate, g_final):
    B, S, _ = x.shape
    A = ATTN_WIDTH
    h = x
    for i in range(DEPTH):
        a = rms_norm(h, g_mix[i])
        proj = a @ w_in[i]
        q = proj[..., :A].reshape(B, S, N_HEADS, HEAD_DIM)
        k = proj[..., A:2 * A].reshape(B, S, N_HEADS, HEAD_DIM)
        v = proj[..., 2 * A:3 * A].reshape(B, S, N_HEADS, HEAD_DIM)
        u = proj[..., 3 * A:]
        o_attn = moba_attention(q, k, v)
        o_pool = pool_mixer(u, w_pool[i])
        mixed = jnp.concatenate([rms_norm(o_attn, beta_attn[i]),
                                 rms_norm(o_pool, pool_scale[i])], axis=-1)
        h = h + mixed @ w_out[i]
        f = rms_norm(h, g_ffn[i])
        h = h + hier_moe(f, w_router_group[i], b_router_group[i], w_router_expert[i],
                         b_router_expert[i], w_expert_gate[i], w_expert_up[i], w_expert_down[i])
        gate = jax.nn.sigmoid(rms_norm(h, g_ple[i]) @ w_ple_gate[i] + b_ple_gate[i])
        h = h + gate * (p[i] @ w_ple[i])
    return rms_norm(h, g_final)
```

```cpp
#include <hip/hip_runtime.h>
#include <cstdio>
#include <cstdint>

namespace pg8 {
#define PG8_LAS __attribute__((address_space(3)))
typedef unsigned short bf16_t;
typedef short bf16x8 __attribute__((ext_vector_type(8)));
typedef float f32x4 __attribute__((ext_vector_type(4)));
typedef unsigned u32x4 __attribute__((ext_vector_type(4)));
typedef unsigned u32x2 __attribute__((ext_vector_type(2)));
constexpr int BM = 256, BK = 64, HALF = 128, HTB = HALF * BK * 2  , STAGE_BYTES = 8 * HTB, NXCD = 8, WGM = 8;

__host__ __device__ __forceinline__ int lds_byte(int r, int c) { const int st = (r >> 4) * 2 + (c >> 5), rr = r & 15, cc = c & 31, ob = rr * 64 + cc * 2; return st * 1024 + (ob ^ (((ob >> 9) & 1) << 5)); }
__host__ __device__ __forceinline__ void stage_rc(int b, int& R, int& C) { const int st = b / 1024, sb = b % 1024, swz = sb ^ (((sb >> 9) & 1) << 5); R = (st >> 1) * 16 + swz / 64; C = (st & 1) * 32 + (swz % 64) / 2; }
__host__ __device__ __forceinline__ int perm32(int rho) { const int n = rho >> 4, i = rho & 15; return 8 * (i >> 2) + 4 * n + (i & 3); }

struct Unit { const char* a; const char* b; int pm, pn, x0, x1; };

struct TileOrder {
    int nM, nN, nwg, G, c, L0, lim;
    __device__ __forceinline__ void init(int nM_, int nN_, int G_, int c_) { nM = nM_; nN = nN_; nwg = nM * nN; G = G_; c = c_; L0 = 0; lim = nwg; }
    __device__ __forceinline__ bool tile(int i, int& pm, int& pn) const { return map((long)L0 + (long)i * G + c, pm, pn); }
    __device__ __forceinline__ bool map(long L, int& pm, int& pn) const {
        if (c < 0 || L >= lim) return false;
        int wgid = (int)L; { const int q = nwg / NXCD, r = nwg % NXCD, xcd = wgid % NXCD, off = wgid / NXCD; wgid = (xcd < r ? xcd * (q + 1) : r * (q + 1) + (xcd - r) * q) + off; }
        const int nig = WGM * nN, gid = wgid / nig, fm = gid * WGM, gsz = (nM - fm) < WGM ? (nM - fm) : WGM;
        pm = fm + ((wgid % nig) % gsz); pn = (wgid % nig) / gsz; return true;
    }
};

__device__ __forceinline__ unsigned cvt_pk_bf16(float lo, float hi) { unsigned r; asm volatile("v_cvt_pk_bf16_f32 %0, %1, %2" : "=v"(r) : "v"(lo), "v"(hi)); return r; }

#ifndef GEMM_ALIGN
#define GEMM_ALIGN true
#endif
#ifndef GEMM_SP2
#define GEMM_SP2 true
#endif
#ifndef EPI_RELAX
#define EPI_RELAX 1
#endif
template <class Epi, class Sched, bool GATHER, bool ALIGN_EPI = GEMM_ALIGN, bool SP2 = GEMM_SP2, bool HALFN = false>
__device__ __forceinline__ void gemm_phase(PG8_LAS unsigned char* lds, const unsigned lda, const int K, const Sched& S, const Epi& E, const int ldb_ = 0) {
    const int tid = threadIdx.x, wid = __builtin_amdgcn_readfirstlane(tid >> 6), lane = tid & 63, wr = wid >> 2, wc = wid & 3, fr = lane & 15, fq = lane >> 4;
    const int nt = K / BK, ldb = ldb_ ? ldb_ : K;
    unsigned voffB[2]; int RA[2], CA[2];
#pragma unroll
    for (int i = 0; i < 2; ++i) { int R, C; stage_rc(tid * 16 + i * 8192, R, C); const int Rb = Epi::PERM ? ((R & ~31) + perm32(R & 31)) : R;
        RA[i] = R; CA[i] = C; voffB[i] = (unsigned)(Rb * ldb + C) * 2u; }
    const size_t kstep = (size_t)(BK * 2);
    const size_t hstepB = (size_t)HALF * ldb * 2;
    const unsigned ldsw = (unsigned)wid * 1024u;
    const int aoff = lds_byte(wr * 64 + fr, fq * 8), boff = lds_byte(wc * 32 + fr, fq * 8);
#define PG8_SA(b, h) (((b) * 2 + (h)) * HTB)
#define PG8_SB(b, h) ((4 + (b) * 2 + (h)) * HTB)
#define PG8_STAGE(bufoff, gbase, voff) do { _Pragma("unroll") for (int _i = 0; _i < 2; ++_i) \
        __builtin_amdgcn_global_load_lds((const unsigned*)((const char*)(gbase) + (voff)[_i]), (PG8_LAS unsigned*)(lds + (bufoff) + ldsw + _i * 8192), 16, 0, 0); } while (0)
#define PG8_STAGE2(bufoff, gbase, v0, v1) do { \
        __builtin_amdgcn_global_load_lds((const unsigned*)((const char*)(gbase) + (v0)), (PG8_LAS unsigned*)(lds + (bufoff) + ldsw), 16, 0, 0); \
        __builtin_amdgcn_global_load_lds((const unsigned*)((const char*)(gbase) + (v1)), (PG8_LAS unsigned*)(lds + (bufoff) + ldsw + 8192), 16, 0, 0); } while (0)
#define PG8_LDA(dst, b, h) do { _Pragma("unroll") for (int m = 0; m < 4; ++m) _Pragma("unroll") for (int k = 0; k < 2; ++k) dst[m][k] = *(const PG8_LAS bf16x8*)(lds + PG8_SA(b, h) + aoff + m * 2048 + k * 1024); } while (0)
#define PG8_LDB(dst, b, h) do { _Pragma("unroll") for (int n = 0; n < 2; ++n) _Pragma("unroll") for (int k = 0; k < 2; ++k) dst[n][k] = *(const PG8_LAS bf16x8*)(lds + PG8_SB(b, h) + boff + n * 2048 + k * 1024); } while (0)
#define PG8_MMA(ai, bj, At, Bt) do { __builtin_amdgcn_s_setprio(1); _Pragma("unroll") for (int m = 0; m < 4; ++m) _Pragma("unroll") for (int n = 0; n < 2; ++n) _Pragma("unroll") for (int k = 0; k < 2; ++k) \
        acc[ai][bj][m][n] = __builtin_amdgcn_mfma_f32_16x16x32_bf16(Bt[n][k], At[m][k], acc[ai][bj][m][n], 0, 0, 0); __builtin_amdgcn_s_setprio(0); } while (0)
#define PG8_WAIT_V(n) asm volatile("s_waitcnt vmcnt(" #n ")" ::: "memory")
#define PG8_WAIT_L(n) asm volatile("s_waitcnt lgkmcnt(" #n ")" ::: "memory")
#define PG8_WAIT_V8_OR_24(r) asm volatile("s_cmp_lg_u32 %0, 0\n\ts_cbranch_scc1 1f\n\ts_waitcnt vmcnt(8)\n1:\n\ts_waitcnt vmcnt(24)" :: "s"(r) : "memory", "scc")
#define PG8_BAR __builtin_amdgcn_s_barrier()
#define PG8_SCHED __builtin_amdgcn_sched_barrier(0)
    Unit cur, nxt; int ui = 0;
    if (!S.next(0, cur)) return;
    unsigned c00, c01, c10, c11, n00 = 0, n01 = 0, n10 = 0, n11 = 0;
    if constexpr (GATHER) {
        c00 = S.row_off(cur, RA[0]) + CA[0] * 2u; c01 = S.row_off(cur, RA[1]) + CA[1] * 2u; c10 = S.row_off(cur, HALF + RA[0]) + CA[0] * 2u; c11 = S.row_off(cur, HALF + RA[1]) + CA[1] * 2u;
    } else {
        c00 = (unsigned)RA[0] * lda + CA[0] * 2u; c01 = (unsigned)RA[1] * lda + CA[1] * 2u; c10 = c00 + HALF * lda; c11 = c01 + HALF * lda;
    }
    f32x4 acc[2][2][4][2];
#pragma unroll
    for (int a = 0; a < 2; ++a)
#pragma unroll
        for (int b = 0; b < 2; ++b)
#pragma unroll
            for (int m = 0; m < 4; ++m)
#pragma unroll
                for (int n = 0; n < 2; ++n) acc[a][b][m][n] = (f32x4){0.f, 0.f, 0.f, 0.f};
    bf16x8 At[4][2], B0[2][2], B1[2][2];
    const char* cA = cur.a; const char* cB = cur.b;
    if constexpr (SP2) {
        PG8_STAGE(PG8_SB(0, 0), cB, voffB); PG8_STAGE(PG8_SB(0, 1), cB + hstepB, voffB); PG8_STAGE2(PG8_SA(0, 0), cA, c00, c01); PG8_STAGE2(PG8_SA(0, 1), cA, c10, c11);
        if (wr == 1) PG8_BAR;
        PG8_WAIT_V(2); PG8_BAR;
        PG8_STAGE(PG8_SB(1, 0), cB + kstep, voffB); PG8_STAGE2(PG8_SA(1, 0), cA + kstep, c00, c01); PG8_STAGE(PG8_SB(1, 1), cB + hstepB + kstep, voffB);
        PG8_WAIT_V(6); PG8_BAR;
    } else {
        PG8_STAGE(PG8_SB(0, 0), cB, voffB); PG8_STAGE2(PG8_SA(0, 0), cA, c00, c01); PG8_STAGE(PG8_SB(0, 1), cB + hstepB, voffB); PG8_STAGE2(PG8_SA(0, 1), cA, c10, c11);
        if (wr == 1) PG8_BAR;
        PG8_WAIT_V(4); PG8_BAR;
        PG8_STAGE(PG8_SB(1, 0), cB + kstep, voffB); PG8_STAGE2(PG8_SA(1, 0), cA + kstep, c00, c01); PG8_STAGE(PG8_SB(1, 1), cB + hstepB + kstep, voffB);
        PG8_WAIT_V(6); PG8_BAR;
    }
    for (;;) {
        const bool has_next = S.next(ui + 1, nxt);
        const char* nA = has_next ? nxt.a : cA; const char* nB = has_next ? nxt.b : cB;
        if constexpr (GATHER) {
            if (has_next) { n00 = S.row_off(nxt, RA[0]) + CA[0] * 2u; n01 = S.row_off(nxt, RA[1]) + CA[1] * 2u; n10 = S.row_off(nxt, HALF + RA[0]) + CA[0] * 2u; n11 = S.row_off(nxt, HALF + RA[1]) + CA[1] * 2u; }
            else { n00 = c00; n01 = c01; n10 = c10; n11 = c11; }
        }
        for (int t = 0; t < nt; t += 2) {
            const bool last = (t == nt - 2);
            const char* a1 = cA + (size_t)(t + 1) * kstep;
            const char* a2 = last ? nA : cA + (size_t)(t + 2) * kstep; const char* b2 = last ? nB : cB + (size_t)(t + 2) * kstep;
            const char* a3 = a2 + kstep; const char* b3 = b2 + kstep;
            unsigned v00 = c00, v01 = c01, v10 = c10, v11 = c11;
            if constexpr (GATHER) { if (last) { v00 = n00; v01 = n01; v10 = n10; v11 = n11; } }
            if constexpr (SP2) {
            const int rel = __builtin_amdgcn_readfirstlane(((Epi::NST == 16) && EPI_RELAX && (t == 0) && (ui > 0)) ? 1 : 0);
            PG8_LDB(B0, 0, 0); if constexpr (!HALFN) PG8_LDB(B1, 0, 1); PG8_SCHED; PG8_LDA(At, 0, 0); PG8_STAGE2(PG8_SA(1, 1), a1, c10, c11);
            PG8_WAIT_V8_OR_24(rel);
            PG8_WAIT_L(0); PG8_BAR; PG8_MMA(0, 0, At, B0); if constexpr (!HALFN) PG8_MMA(0, 1, At, B1); PG8_BAR; PG8_SCHED;
            PG8_LDA(At, 0, 1); PG8_STAGE(PG8_SB(0, 0), b2, voffB); PG8_STAGE(PG8_SB(0, 1), b2 + hstepB, voffB); PG8_STAGE2(PG8_SA(0, 0), a2, v00, v01);
            PG8_WAIT_V8_OR_24(rel);
            PG8_WAIT_L(0); PG8_BAR; PG8_MMA(1, 0, At, B0); if constexpr (!HALFN) PG8_MMA(1, 1, At, B1); PG8_BAR; PG8_SCHED;
            PG8_LDB(B0, 1, 0); if constexpr (!HALFN) PG8_LDB(B1, 1, 1); PG8_SCHED; PG8_LDA(At, 1, 0); PG8_STAGE2(PG8_SA(0, 1), a2, v10, v11);
            PG8_WAIT_V(8); PG8_WAIT_L(0); PG8_BAR; PG8_MMA(0, 0, At, B0); if constexpr (!HALFN) PG8_MMA(0, 1, At, B1); PG8_BAR; PG8_SCHED;
            PG8_LDA(At, 1, 1); PG8_STAGE(PG8_SB(1, 0), b3, voffB); PG8_STAGE(PG8_SB(1, 1), b3 + hstepB, voffB); PG8_STAGE2(PG8_SA(1, 0), a3, v00, v01);
            PG8_WAIT_V(8); PG8_WAIT_L(0); PG8_BAR; PG8_MMA(1, 0, At, B0); if constexpr (!HALFN) PG8_MMA(1, 1, At, B1); PG8_BAR; PG8_SCHED;
            } else {
            PG8_LDB(B0, 0, 0); PG8_SCHED; PG8_LDA(At, 0, 0); PG8_STAGE2(PG8_SA(1, 1), a1, c10, c11);
            PG8_WAIT_L(8); PG8_BAR; PG8_WAIT_L(0); PG8_MMA(0, 0, At, B0); PG8_BAR; PG8_SCHED;
            PG8_LDB(B1, 0, 1); PG8_STAGE(PG8_SB(0, 0), b2, voffB);
            PG8_BAR; PG8_WAIT_L(0); PG8_MMA(0, 1, At, B1); PG8_BAR;
            PG8_LDA(At, 0, 1); PG8_STAGE2(PG8_SA(0, 0), a2, v00, v01);
            PG8_BAR; PG8_WAIT_L(0); PG8_MMA(1, 0, At, B0); PG8_BAR; PG8_SCHED;
            PG8_STAGE(PG8_SB(0, 1), b2 + hstepB, voffB);
            PG8_WAIT_V(6); PG8_BAR; PG8_MMA(1, 1, At, B1); PG8_BAR;
            PG8_LDB(B0, 1, 0); PG8_SCHED; PG8_LDA(At, 1, 0); PG8_STAGE2(PG8_SA(0, 1), a2, v10, v11);
            PG8_WAIT_L(8); PG8_BAR; PG8_WAIT_L(0); PG8_MMA(0, 0, At, B0); PG8_BAR; PG8_SCHED;
            PG8_LDB(B1, 1, 1); PG8_STAGE(PG8_SB(1, 0), b3, voffB);
            PG8_BAR; PG8_WAIT_L(0); PG8_MMA(0, 1, At, B1); PG8_BAR;
            PG8_LDA(At, 1, 1); PG8_STAGE2(PG8_SA(1, 0), a3, v00, v01);
            PG8_BAR; PG8_WAIT_L(0); PG8_MMA(1, 0, At, B0); PG8_BAR; PG8_SCHED;
            PG8_STAGE(PG8_SB(1, 1), b3 + hstepB, voffB);
            PG8_WAIT_V(6); PG8_BAR; PG8_MMA(1, 1, At, B1); PG8_BAR;
            }
        }
        if constexpr (ALIGN_EPI) { if (wr == 0) PG8_BAR; }
        E(acc, cur, wr, wc, fr, fq);
        if (!has_next) break;
#pragma unroll
        for (int a = 0; a < 2; ++a)
#pragma unroll
            for (int b = 0; b < 2; ++b)
#pragma unroll
                for (int m = 0; m < 4; ++m)
#pragma unroll
                    for (int n = 0; n < 2; ++n) acc[a][b][m][n] = (f32x4){0.f, 0.f, 0.f, 0.f};
        cur = nxt; cA = nA; cB = nB; ++ui;
        if constexpr (GATHER) { c00 = n00; c01 = n01; c10 = n10; c11 = n11; }
        if constexpr (ALIGN_EPI) { if (wr == 1) PG8_BAR; }
    }
    PG8_WAIT_V(0);
    if constexpr (!ALIGN_EPI) { if (wr == 0) PG8_BAR; }
    PG8_BAR;
#undef PG8_SA
#undef PG8_SB
#undef PG8_STAGE
#undef PG8_STAGE2
#undef PG8_LDA
#undef PG8_LDB
#undef PG8_MMA
#undef PG8_WAIT_V
#undef PG8_WAIT_L
#undef PG8_BAR
#undef PG8_SCHED
}
}

constexpr int NWAVES = 8;
constexpr int BATCH = 4, SEQ = 8192, DM = 2048, T = BATCH * SEQ;
constexpr int AW = 1024, NH = 8, HD = 128, MBLK = 256, NBLK = SEQ / MBLK, TOPK = 3;
constexpr int PW = 1024, NPG = 4, PG = 256;
constexpr int NIN = 3 * AW + PW;
constexpr int NGRP = 8, EPG = 8, NE = 64, DE = 512;
constexpr int PLE = 256;
constexpr float EPS = 1e-6f;
constexpr int NSLOT = 2 * T;
constexpr int PMAX = NSLOT + NE * 256;
constexpr int MAXTILES = PMAX / 256;

constexpr size_t MiB = 1u << 20;
constexpr size_t WS_CTL = 0, CTL_ZERO_BYTES = 1 * MiB;
constexpr size_t WS_WIN = 2 * MiB;
constexpr size_t WS_WPOOL = 18 * MiB;
constexpr size_t WS_WOUT = 19 * MiB;
constexpr size_t WS_WR = 27 * MiB;
constexpr size_t WS_WPG = 28 * MiB;
constexpr size_t WS_WPLE = 36 * MiB;
constexpr size_t WS_WGU = 40 * MiB;
constexpr size_t WS_WD = 296 * MiB;
constexpr size_t WS_XN = 424 * MiB;
constexpr size_t WS_PROJ = 552 * MiB;
constexpr size_t WS_MIX = 808 * MiB;
constexpr size_t WS_Z = 936 * MiB;
constexpr size_t WS_PBF = 1000 * MiB;
constexpr size_t WS_KMEAN = 1016 * MiB;
constexpr size_t WS_RS3 = 1020 * MiB;
constexpr size_t WS_SSQ = 936 * MiB + 8 * MiB;
constexpr size_t WS_RSF = 1021 * MiB;
constexpr size_t WS_ERS = 1024 * MiB;
constexpr size_t WS_RS0 = 1022 * MiB;
constexpr size_t WS_LOGIT = 1060 * MiB;
constexpr size_t WS_ROUTE = 1033 * MiB;
constexpr size_t WS_END = 1057 * MiB;
constexpr size_t RT_ELIST = 0, RT_EWL = 8 * MiB;
constexpr int CW_TMO = 0, CW_CODE = 1;
constexpr int CW_BAR = 4096;
constexpr int CW_ECNT = 16384;
constexpr int CW_EFILL = 16384 + 256;

constexpr int RING_OFF = 0, RING_BYTES = 131072;
constexpr int SCR_BYTES = 133120;
constexpr int LDSCTL_OFF = 135168, MISC_OFF = LDSCTL_OFF;
constexpr int TAB_OFF = LDSCTL_OFF + 256;
constexpr int LDS_BYTES = 163840;

#define GAS __attribute__((address_space(1)))
#define LAS __attribute__((address_space(3)))
typedef unsigned short bf16;
typedef unsigned v4u __attribute__((ext_vector_type(4)));
typedef unsigned v2u __attribute__((ext_vector_type(2)));
typedef float f32x4 __attribute__((ext_vector_type(4)));
typedef GAS unsigned gu32;
#define RLX_AGENT __ATOMIC_RELAXED, __HIP_MEMORY_SCOPE_AGENT
#define LDS_WAIT() asm volatile("s_waitcnt lgkmcnt(0)" ::: "memory")
#define VM_WAIT() asm volatile("s_waitcnt vmcnt(0)" ::: "memory")
typedef float f32x2_t __attribute__((ext_vector_type(2)));
typedef __bf16 bf16x2_t __attribute__((ext_vector_type(2)));
__device__ __forceinline__ unsigned pk2(float lo, float hi) { const f32x2_t v = {lo, hi}; return __builtin_bit_cast(unsigned, __builtin_convertvector(v, bf16x2_t)); }
__device__ __forceinline__ unsigned f2bf(float f) { return pk2(f, 0.f) & 0xffffu; }
__device__ __forceinline__ float bflo(unsigned w) { return __builtin_bit_cast(float, w << 16); }
__device__ __forceinline__ float bfhi(unsigned w) { return __builtin_bit_cast(float, w & 0xffff0000u); }
__device__ __forceinline__ float wave_sum(float v) {
#pragma unroll
    for (int o = 1; o < 64; o <<= 1) v += __shfl_xor(v, o);
    return v;
}
__device__ __forceinline__ float wave_max(float v) {
#pragma unroll
    for (int o = 1; o < 64; o <<= 1) v = fmaxf(v, __shfl_xor(v, o));
    return v;
}
#define XB_TMO      128
#define XB_XCNT(j)  (256  + 64 * (j))
#define XB_XSUB(j)  (1280 + 64 * (j))
#define XB_XGEN(j)  (2304 + 64 * (j))
#define XB_TOP      3328
#define XB_TOPGEN   3392
#define XCD_BAR_WORDS 3456
#define XB_SPIN_CAP (1u << 23)

__device__ __forceinline__ unsigned xb_ld(unsigned* p)              { return __hip_atomic_load(p, __ATOMIC_RELAXED, __HIP_MEMORY_SCOPE_AGENT); }
__device__ __forceinline__ unsigned xb_add(unsigned* p, unsigned v) { return __hip_atomic_fetch_add(p, v, __ATOMIC_RELAXED, __HIP_MEMORY_SCOPE_AGENT); }
__device__ __forceinline__ unsigned xb_xcc_id() { return (unsigned)__builtin_amdgcn_s_getreg((3 << 11) | 20) & 0xFu; }
#define XB_SPIN(cond, bar) do { unsigned _sp = 0; while (cond) { __builtin_amdgcn_s_sleep(1); \
    if ((++_sp & 255u) == 0u) { if (xb_ld(&(bar)[XB_TMO])) break; if (_sp > XB_SPIN_CAP) { atomicAdd(&(bar)[XB_TMO], 1u); break; } } } } while (0)

struct XcdBarrier {
    unsigned* bar; unsigned x;
    volatile LAS unsigned* st;
};

__device__ __forceinline__ XcdBarrier xcd_barrier_post(unsigned* bar, volatile LAS unsigned* st) {
    XcdBarrier b; b.bar = bar; b.x = xb_xcc_id(); b.st = st;
    if (threadIdx.x == 0) (void)xb_add(&bar[XB_XCNT(b.x)], 1u);
    return b;
}
__device__ __forceinline__ void xcd_barrier_complete(unsigned* bar, unsigned x, unsigned& nloc, unsigned& nx) {
    const unsigned G = gridDim.x * gridDim.y * gridDim.z;
    unsigned sum, cnt, mine, sp = 0u;
    for (;;) {
        sum = 0u; cnt = 0u; mine = 0u;
#pragma unroll
        for (unsigned j = 0; j < 16; ++j) { const unsigned c = xb_ld(&bar[XB_XCNT(j)]); sum += c; cnt += (c > 0u) ? 1u : 0u; mine = (j == x) ? c : mine; }
        if (sum == G) break;
        __builtin_amdgcn_s_sleep(1);
        if ((++sp & 255u) == 0u) { if (xb_ld(&bar[XB_TMO])) break; if (sp > XB_SPIN_CAP) { atomicAdd(&bar[XB_TMO], 1u); break; } }
    }
    nloc = mine > 0u ? mine : 1u; nx = cnt > 0u ? cnt : 1u;
}

__device__ __forceinline__ void xcd_barrier(const XcdBarrier& b) {
    asm volatile("s_waitcnt vmcnt(0)" ::: "memory");
    __syncthreads();
    if (threadIdx.x == 0) {
        unsigned* bar = b.bar;
        __builtin_amdgcn_s_waitcnt(0);
        unsigned nloc = b.st[0], nx = b.st[1];
        if (nloc == 0u) { xcd_barrier_complete(bar, b.x, nloc, nx); b.st[0] = nloc; b.st[1] = nx; }
        const unsigned old = xb_add(&bar[XB_XSUB(b.x)], 1u);
        const unsigned gen = old / nloc;
        if (old + 1u == (gen + 1u) * nloc) {
            __builtin_amdgcn_fence(__ATOMIC_RELEASE, "agent");
            asm volatile("s_waitcnt vmcnt(0)" ::: "memory");
            const unsigned og = xb_add(&bar[XB_TOP], 1u);
            const unsigned tg = og / nx;
            if (og + 1u == (tg + 1u) * nx) xb_add(&bar[XB_TOPGEN], 1u);
            else XB_SPIN(xb_ld(&bar[XB_TOPGEN]) == tg, bar);
            __builtin_amdgcn_fence(__ATOMIC_ACQUIRE, "agent");
            xb_add(&bar[XB_XGEN(b.x)], 1u);
            asm volatile("s_waitcnt vmcnt(0)" ::: "memory");
        } else {
            XB_SPIN(xb_ld(&bar[XB_XGEN(b.x)]) == gen, bar);
            __builtin_amdgcn_fence(__ATOMIC_ACQUIRE, "agent");
            asm volatile("s_waitcnt vmcnt(0)" ::: "memory");
        }
    }
    __syncthreads();
}

struct Frame {
    LAS unsigned char* lds; unsigned char* ldsg;
    volatile LAS unsigned* MISC;
    gu32* ctl;
    int tid, lane, wave;
    int vcu, G;
    const float *x, *p, *g_mix, *w_in, *beta_attn, *w_pool, *pool_scale, *w_out, *g_ffn, *w_rg, *b_rg, *w_re, *b_re, *w_eg, *w_eu, *w_ed, *g_ple, *w_ple, *w_pg, *b_pg, *g_final;
    float* out; unsigned char* ws;
};
#define WSP(T_, off) ((T_*)(F.ws + (off)))

struct KmId { __device__ __forceinline__ int operator()(int k) const { return k; } };
struct KmAttn { __device__ __forceinline__ int operator()(int k) const { return k < AW ? ((k & ~127) + 32 * (k & 3) + ((k & 127) >> 2)) : k; } };
template <class RowMap, class KMap = KmId>
__device__ __forceinline__ void tr64_item(const float* W, int ldw, bf16* WT, int ldt, int k0, int n0, const RowMap& rm, LAS float* scr, int lane, const KMap& km = KMap(), const float* kg = nullptr) {
    f32x4 v[16];
#pragma unroll
    for (int i = 0; i < 16; ++i) { const int k = 4 * i + (lane >> 4), n4 = (lane & 15) * 4; v[i] = *(const GAS f32x4*)(W + (size_t)km(k0 + k) * ldw + n0 + n4); }
#pragma unroll
    for (int i = 0; i < 16; ++i) { const int k = 4 * i + (lane >> 4), n4 = (lane & 15) * 4;
        LAS float* s = scr + k * 65 + n4; const float gk = kg ? kg[k0 + k] : 1.f; s[0] = v[i].x * gk; s[1] = v[i].y * gk; s[2] = v[i].z * gk; s[3] = v[i].w * gk; }
    LDS_WAIT();
    const int c = lane & 7;
#pragma unroll
    for (int j = 0; j < 8; ++j) { const int n = (lane >> 3) + 8 * j; const LAS float* s = scr + (8 * c) * 65 + n;
        v4u o; o.x = pk2(s[0 * 65], s[1 * 65]); o.y = pk2(s[2 * 65], s[3 * 65]); o.z = pk2(s[4 * 65], s[5 * 65]); o.w = pk2(s[6 * 65], s[7 * 65]);
        *(GAS v4u*)(WT + (size_t)rm(n0 + n) * ldt + k0 + 8 * c) = o; }
    LDS_WAIT();
}
struct RmId { __device__ __forceinline__ int operator()(int n) const { return n; } };
template <class KMap = KmId>
__device__ __forceinline__ void tr64_load(const float* W, int ldw, int k0, int n0, int lane, f32x4 (&v)[16], const KMap& km = KMap()) {
#pragma unroll
    for (int i = 0; i < 16; ++i) { const int k = 4 * i + (lane >> 4), n4 = (lane & 15) * 4; v[i] = __builtin_nontemporal_load((const GAS f32x4*)(W + (size_t)km(k0 + k) * ldw + n0 + n4)); }
}
template <class RowMap>
__device__ __forceinline__ void tr64_finish(const f32x4 (&v)[16], bf16* WT, int ldt, int k0, int n0, const RowMap& rm, LAS float* scr, int lane, const float* kg = nullptr) {
#pragma unroll
    for (int i = 0; i < 16; ++i) { const int k = 4 * i + (lane >> 4), n4 = (lane & 15) * 4;
        LAS float* s = scr + k * 65 + n4; const float gk = kg ? kg[k0 + k] : 1.f; s[0] = v[i].x * gk; s[1] = v[i].y * gk; s[2] = v[i].z * gk; s[3] = v[i].w * gk; }
    LDS_WAIT();
    const int c = lane & 7;
#pragma unroll
    for (int j = 0; j < 8; ++j) { const int n = (lane >> 3) + 8 * j; const LAS float* s = scr + (8 * c) * 65 + n;
        v4u o; o.x = pk2(s[0 * 65], s[1 * 65]); o.y = pk2(s[2 * 65], s[3 * 65]); o.z = pk2(s[4 * 65], s[5 * 65]); o.w = pk2(s[6 * 65], s[7 * 65]);
        __builtin_nontemporal_store(o, (GAS v4u*)(WT + (size_t)rm(n0 + n) * ldt + k0 + 8 * c)); }
    LDS_WAIT();
}

struct RmGU { int add; __device__ __forceinline__ int operator()(int n) const { return ((n >> 2) << 3) + (n & 3) + add; } };

__device__ __forceinline__ void row_load(const float* row, int lane, f32x4 (&v)[8]) {
    const GAS f32x4* xr = (const GAS f32x4*)row + lane;
#pragma unroll
    for (int j = 0; j < 8; ++j) v[j] = xr[64 * j];
}
__device__ __forceinline__ void row_load_nt(const float* row, int lane, f32x4 (&v)[8]) {
    const GAS f32x4* xr = (const GAS f32x4*)row + lane;
#pragma unroll
    for (int j = 0; j < 8; ++j) v[j] = __builtin_nontemporal_load(xr + 64 * j);
}
__device__ __forceinline__ float row_ss(const f32x4 (&v)[8]) {
    float s = 0.f;
#pragma unroll
    for (int j = 0; j < 8; ++j) s += (v[j].x * v[j].x + v[j].y * v[j].y) + (v[j].z * v[j].z + v[j].w * v[j].w);
    return wave_sum(s);
}
__device__ __forceinline__ void row_norm_bf16(const f32x4 (&v)[8], float ss, const float* gain, bf16* orow, int lane) {
    const float r = 1.0f / sqrtf(ss * (1.f / DM) + EPS);
    GAS unsigned long long* o8 = (GAS unsigned long long*)orow + lane;
    const GAS f32x4* g4 = (const GAS f32x4*)gain + lane;
#pragma unroll
    for (int j = 0; j < 8; ++j) { const f32x4 g = g4[64 * j];
        o8[64 * j] = (unsigned long long)pk2(v[j].x * r * g.x, v[j].y * r * g.y) | ((unsigned long long)pk2(v[j].z * r * g.z, v[j].w * r * g.w) << 32); }
}

__device__ __forceinline__ void row_norm_bf16_g(const f32x4 (&v)[8], float ss, const f32x4 (&g)[8], bf16* orow, int lane) {
    const float r = 1.0f / sqrtf(ss * (1.f / DM) + EPS);
    GAS unsigned long long* o8 = (GAS unsigned long long*)orow + lane;
#pragma unroll
    for (int j = 0; j < 8; ++j)
        o8[64 * j] = (unsigned long long)pk2(v[j].x * r * g[j].x, v[j].y * r * g[j].y) | ((unsigned long long)pk2(v[j].z * r * g[j].z, v[j].w * r * g[j].w) << 32);
}
__device__ __forceinline__ void p0_prologue(Frame& F) {
    LAS float* scr = (LAS float*)(F.lds + F.wave * 16640);
    const int gw = F.vcu * NWAVES + F.wave, NGW = F.G * NWAVES;
    constexpr int I_WIN = 32 * 64;
    for (int it = gw; it < I_WIN; it += NGW) tr64_item(F.w_in, NIN, WSP(bf16, WS_WIN), DM, 64 * (it / 64), 64 * (it % 64), RmId{}, scr, F.lane, KmId{}, F.g_mix);
    const int gt = F.vcu * (NWAVES * 64) + F.tid, NGT = F.G * NWAVES * 64;
    { bf16* wr = WSP(bf16, WS_WR);
      for (int i = gt; i < 256 * DM; i += NGT) { const int n = i / DM, k = i % DM; float v = 0.f;
          if (n < 8) v = F.w_rg[k * 8 + n]; else if (n < 72) { const int g = (n - 8) >> 3, e = (n - 8) & 7; v = F.w_re[((size_t)g * DM + k) * 8 + e]; }
          wr[i] = (bf16)f2bf(v * F.g_ffn[k]); } }
    { const GAS f32x4* ps = (const GAS f32x4*)F.p; GAS v2u* pd = (GAS v2u*)WSP(bf16, WS_PBF);
      static_assert((T * PLE / 4) % (256 * NWAVES * 64 * 8) == 0, "p copy: eight loads per trip");
      if (F.G == 256) {
        for (int i = gt; i < T * PLE / 4; i += 8 * NGT) { f32x4 v[8];
#pragma unroll
            for (int k = 0; k < 8; ++k) v[k] = __builtin_nontemporal_load(ps + i + k * NGT);
#pragma unroll
            for (int k = 0; k < 8; ++k) { v2u o; o.x = pk2(v[k].x, v[k].y); o.y = pk2(v[k].z, v[k].w); pd[i + k * NGT] = o; } }
      } else for (int i = gt; i < T * PLE / 4; i += NGT) { const f32x4 v = ps[i]; v2u o; o.x = pk2(v.x, v.y); o.y = pk2(v.z, v.w); pd[i] = o; } }
    { float* ones = WSP(float, WS_RS0) + 65536; for (int i = gt; i < T; i += NGT) ones[i] = 1.0f; }
    { f32x4 v[8]; row_load_nt(F.x + (size_t)gw * DM, F.lane, v); VM_WAIT();
      for (int m = gw; m < T; m += NGW) { const int mn = (m + NGW < T) ? m + NGW : m; f32x4 vn[8]; row_load_nt(F.x + (size_t)mn * DM, F.lane, vn);
          const float ss = row_ss(v); if (F.lane == 0) WSP(float, WS_RS0)[m] = 1.0f / sqrtf(ss * (1.f / DM) + EPS);
          { GAS unsigned long long* o8 = (GAS unsigned long long*)(WSP(bf16, WS_XN) + (size_t)m * DM) + F.lane;
#pragma unroll
            for (int j = 0; j < 8; ++j) o8[64 * j] = (unsigned long long)pk2(v[j].x, v[j].y) | ((unsigned long long)pk2(v[j].z, v[j].w) << 32); }
#pragma unroll
          for (int j = 0; j < 8; ++j) v[j] = vn[j]; } }
}

struct ConvItem { const float* W; bf16* WT; int ldw, ldt, k0, n0, add, kperm; const float* kg; };
__device__ __forceinline__ ConvItem conv_item(Frame& F, int it) {
    constexpr int I_POOL = 4 * 16, I_WOUT = 32 * 32, I_WPG = 32 * 32, I_WPLE = 4 * 32, I_EG = 64 * 256; ConvItem c; int r = it; c.add = -1; c.kperm = 0; c.kg = nullptr;
    if (r < I_POOL) { const int g = r / 16, q = r % 16; c.W = F.w_pool + (size_t)g * PG * PG; c.ldw = PG; c.WT = WSP(bf16, WS_WPOOL) + (size_t)g * PG * PG; c.ldt = PG; c.k0 = 64 * (q / 4); c.n0 = 64 * (q % 4); return c; } r -= I_POOL;
    if (r < I_WOUT) { c.W = F.w_out; c.ldw = DM; c.WT = WSP(bf16, WS_WOUT); c.ldt = DM; c.k0 = 64 * (r / 32); c.n0 = 64 * (r % 32); c.kperm = 1; return c; } r -= I_WOUT;
    if (r < I_WPG) { c.W = F.w_pg; c.ldw = DM; c.WT = WSP(bf16, WS_WPG); c.ldt = DM; c.k0 = 64 * (r / 32); c.n0 = 64 * (r % 32); c.kg = F.g_ple; return c; } r -= I_WPG;
    if (r < I_WPLE) { c.W = F.w_ple; c.ldw = DM; c.WT = WSP(bf16, WS_WPLE); c.ldt = PLE; c.k0 = 64 * (r / 32); c.n0 = 64 * (r % 32); return c; } r -= I_WPLE;
    if (r < 2 * I_EG) { const bool up = r >= I_EG; r -= up ? I_EG : 0; const int e = r / 256, q = r % 256;
        c.W = (up ? F.w_eu : F.w_eg) + (size_t)e * DM * DE; c.ldw = DE; c.WT = WSP(bf16, WS_WGU) + (size_t)e * 1024 * DM; c.ldt = DM; { const int g = q >> 3, w = q & 7; c.k0 = 64 * (4 * (g >> 2) + (w >> 1)); c.n0 = 64 * (2 * (g & 3) + (w & 1)); }        c.add = up ? 4 : 0; c.kg = F.g_ffn; return c; }
    r -= 2 * I_EG; { const int e = r / 256, q = r % 256;
        c.W = F.w_ed + (size_t)e * DE * DM; c.ldw = DM; c.WT = WSP(bf16, WS_WD) + (size_t)e * DM * DE; c.ldt = DE; { const int g = q >> 3, w = q & 7; c.k0 = 64 * (4 * (g >> 4) + (w >> 1)); c.n0 = 64 * (2 * (g & 15) + (w & 1)); } }
    return c;
}
struct RmAny { int add; __device__ __forceinline__ int operator()(int n) const { return add < 0 ? n : ((n >> 2) << 3) + (n & 3) + add; } };
struct KmAny { int on; __device__ __forceinline__ int operator()(int k) const { return (on && k < AW) ? ((k & ~127) + 32 * (k & 3) + ((k & 127) >> 2)) : k; } };
__device__ __forceinline__ void conv_experts(Frame& F, int part, int nparts) {
    LAS float* scr = (LAS float*)(F.lds + F.wave * 16640);
    constexpr int NITEMS = 4 * 16 + 32 * 32 + 32 * 32 + 4 * 32 + 3 * 64 * 256; const int step = nparts * NWAVES;
    int it = part * NWAVES + F.wave;
    f32x4 va[16], vb[16];
    if (it < NITEMS) { const ConvItem c = conv_item(F, it); tr64_load(c.W, c.ldw, c.k0, c.n0, F.lane, va, KmAny{c.kperm}); }
    while (it < NITEMS) {
        const ConvItem c0 = conv_item(F, it);
        if (it + step < NITEMS) { const ConvItem c1 = conv_item(F, it + step); tr64_load(c1.W, c1.ldw, c1.k0, c1.n0, F.lane, vb, KmAny{c1.kperm}); }
        tr64_finish(va, c0.WT, c0.ldt, c0.k0, c0.n0, RmAny{c0.add}, scr, F.lane, c0.kg);
        it += step; if (it >= NITEMS) break;
        const ConvItem c2 = conv_item(F, it);
        if (it + step < NITEMS) { const ConvItem c3 = conv_item(F, it + step); tr64_load(c3.W, c3.ldw, c3.k0, c3.n0, F.lane, va, KmAny{c3.kperm}); }
        tr64_finish(vb, c2.WT, c2.ldt, c2.k0, c2.n0, RmAny{c2.add}, scr, F.lane, c2.kg);
        it += step;
    }
}
struct SplitSched {
    pg8::TileOrder ord; const char* A; const char* Bt; size_t a_tile, b_tile; int NC, K1;
    __device__ __forceinline__ bool next(int i, pg8::Unit& u) const {
        int L;
        if (i < K1) L = i * ord.G + ord.c; else { if (ord.c < NC) return false; L = K1 * ord.G + (i - K1) * (ord.G - NC) + (ord.c - NC); }
        int pm, pn; if (!ord.map((long)L, pm, pn)) return false; u.pm = pm; u.pn = pn; u.x0 = 0; u.x1 = 0;
        u.a = A + (size_t)pm * a_tile; u.b = Bt + (size_t)pn * b_tile; return true; }
    __device__ __forceinline__ unsigned row_off(const pg8::Unit&, int) const { return 0u; }
};

struct DenseSched {
    pg8::TileOrder ord; const char* A; const char* Bt; size_t a_tile, b_tile; size_t a_pn_off;
    __device__ __forceinline__ bool next(int i, pg8::Unit& u) const { int pm, pn; if (!ord.tile(i, pm, pn)) return false; u.pm = pm; u.pn = pn; u.x0 = 0; u.x1 = 0;
        u.a = A + (size_t)pm * a_tile + (size_t)pn * a_pn_off; u.b = Bt + (size_t)pn * b_tile; return true; }
    __device__ __forceinline__ unsigned row_off(const pg8::Unit&, int) const { return 0u; }
};
struct MoeSched {
    int TT, NCT, G, c; const LAS int* tile_e; const char* A; const char* Bt; size_t b_exp, b_ct; size_t a_tile; const int* elist; unsigned a_row;
    __device__ __forceinline__ bool next(int i, pg8::Unit& u) const {
        const int L = i * G + c; if (L >= TT * NCT) return false; const int tile = L / NCT, ct = L % NCT; const int e = tile_e[tile];
        const int l0 = (tile - tile_e[MAXTILES + e]) * 256; const int nv = tile_e[MAXTILES + 160 + e] - l0;
        u.pm = nv < 256 ? nv : 256; u.pn = ct; u.x0 = tile * 256; u.x1 = e * T + l0; u.b = Bt + (size_t)e * b_exp + (size_t)ct * b_ct; u.a = A + (size_t)tile * a_tile; return true; }
    __device__ __forceinline__ unsigned row_off(const pg8::Unit& u, int r) const { const int s = elist[u.x1 + (r < u.pm ? r : u.pm - 1)]; return (unsigned)(s >> 1) * a_row; }
};
__device__ __forceinline__ int build_tile_table(Frame& F) {
    LAS int* tab = (LAS int*)(F.lds + TAB_OFF);
    __syncthreads();
    if (F.tid < 64) { const unsigned c = __hip_atomic_load(F.ctl + CW_ECNT + F.tid, RLX_AGENT); tab[MAXTILES + 80 + F.tid] = (int)((c + 255u) >> 8); tab[MAXTILES + 160 + F.tid] = (int)c; }
    __syncthreads();
    if (F.tid == 0) { int s = 0; for (int e = 0; e < 64; ++e) { tab[MAXTILES + e] = s; s += tab[MAXTILES + 80 + e]; } tab[MAXTILES + 64] = s; }
    __syncthreads();
    const int TT = tab[MAXTILES + 64];
    if (F.tid < MAXTILES) { int e = 0; for (int k = 1; k < 64; ++k) e += (tab[MAXTILES + k] <= F.tid) ? 1 : 0; tab[F.tid] = e; }
    __syncthreads();
    return TT;
}

using pg8::f32x4; using pg8::Unit; using pg8::cvt_pk_bf16; using pg8::u32x4; using pg8::u32x2;
template <bool NTS = false> struct EpiBf16T {
    static constexpr bool PERM = true; static constexpr int NST = 16;
    bf16* O; int ldc; int col_base;
    const float* rs;
    __device__ __forceinline__ void operator()(const f32x4 (&acc)[2][2][4][2], const Unit& u, int wr, int wc, int fr, int fq) const {
        const int row0 = u.pm * 256 + wr * 64 + fr, col0 = col_base + u.pn * 256 + wc * 32 + 8 * fq;
        float rsv[2][4];
#pragma unroll
        for (int ai = 0; ai < 2; ++ai)
#pragma unroll
            for (int m = 0; m < 4; ++m) rsv[ai][m] = rs[row0 + ai * 128 + m * 16];
#pragma unroll
        for (int ai = 0; ai < 2; ++ai)
#pragma unroll
            for (int m = 0; m < 4; ++m) { bf16* rowp = O + (size_t)(row0 + ai * 128 + m * 16) * ldc + col0; const float r_ = rsv[ai][m];
#pragma unroll
                for (int bj = 0; bj < 2; ++bj) { const f32x4 v0 = acc[ai][bj][m][0] * r_, v1 = acc[ai][bj][m][1] * r_;
                    u32x4 w; w.x = cvt_pk_bf16(v0[0], v0[1]); w.y = cvt_pk_bf16(v0[2], v0[3]); w.z = cvt_pk_bf16(v1[0], v1[1]); w.w = cvt_pk_bf16(v1[2], v1[3]);
                    if (NTS) { const bf16* p_ = rowp + bj * 128; asm volatile("global_store_dwordx4 %0, %1, off nt\n\ts_nop 1" :: "v"(p_), "v"(w) : "memory"); }
                    else *(GAS u32x4*)(rowp + bj * 128) = w; } }
    }
};
typedef EpiBf16T<false> EpiBf16;
#ifndef EPI_BATCH
#define EPI_BATCH 1
#endif
#if EPI_BATCH
#define EPI_SCHED_BARRIER __builtin_amdgcn_sched_barrier(0)
#else
#define EPI_SCHED_BARRIER do {} while (0)
#endif
struct EpiResBf16 {
    static constexpr bool PERM = true; static constexpr int NST = 16;
    const bf16* base; bf16* C; int ldc; float* ssq;
    __device__ __forceinline__ void operator()(const f32x4 (&acc)[2][2][4][2], const Unit& u, int wr, int wc, int fr, int fq) const {
        const int row0 = u.pm * 256 + wr * 64 + fr, col0 = u.pn * 256 + wc * 32 + 8 * fq;
        float* sq = ssq + (size_t)(4 * u.pn + wc) * T;
#pragma unroll
        for (int ai = 0; ai < 2; ++ai) {
            u32x4 bw[4][2];
#pragma unroll
            for (int m = 0; m < 4; ++m) { const size_t ro = (size_t)(row0 + ai * 128 + m * 16) * ldc + col0;
#pragma unroll
                for (int bj = 0; bj < 2; ++bj) bw[m][bj] = __builtin_nontemporal_load((const GAS u32x4*)(base + ro + bj * 128)); }
            EPI_SCHED_BARRIER;
#pragma unroll
            for (int m = 0; m < 4; ++m) { const size_t ro = (size_t)(row0 + ai * 128 + m * 16) * ldc + col0; float ss = 0.f;
#pragma unroll
                for (int bj = 0; bj < 2; ++bj) {
                    const u32x4 xw = bw[m][bj]; const f32x4 x0 = {bflo(xw.x), bfhi(xw.x), bflo(xw.y), bfhi(xw.y)}, x1 = {bflo(xw.z), bfhi(xw.z), bflo(xw.w), bfhi(xw.w)};
                    const f32x4 v0 = acc[ai][bj][m][0] + x0, v1 = acc[ai][bj][m][1] + x1;
                    ss += (v0[0] * v0[0] + v0[1] * v0[1]) + (v0[2] * v0[2] + v0[3] * v0[3]) + (v1[0] * v1[0] + v1[1] * v1[1]) + (v1[2] * v1[2] + v1[3] * v1[3]);
                    u32x4 w; w.x = cvt_pk_bf16(v0[0], v0[1]); w.y = cvt_pk_bf16(v0[2], v0[3]); w.z = cvt_pk_bf16(v1[0], v1[1]); w.w = cvt_pk_bf16(v1[2], v1[3]);
                    *(GAS u32x4*)(C + ro + bj * 128) = w; }
                ss += __shfl_xor(ss, 16); ss += __shfl_xor(ss, 32);
                if (fq == 0) sq[row0 + ai * 128 + m * 16] = ss; }
            EPI_SCHED_BARRIER;
        }
    }
};
struct EpiLogit {
    static constexpr bool PERM = false; static constexpr int NST = 16;
    float* C;
    __device__ __forceinline__ void operator()(const f32x4 (&acc)[2][2][4][2], const Unit& u, int wr, int wc, int fr, int fq) const {
        const int row0 = u.pm * 256 + wr * 64 + fr, col0 = wc * 32 + 4 * fq; float* Cb = C + (size_t)u.pn * T * 128;
#pragma unroll
        for (int ai = 0; ai < 2; ++ai)
#pragma unroll
            for (int m = 0; m < 4; ++m) { float* rowp = Cb + (size_t)(row0 + ai * 128 + m * 16) * 128 + col0;
#pragma unroll
                for (int n = 0; n < 2; ++n) *(GAS f32x4*)(rowp + n * 16) = acc[ai][0][m][n]; }
    }
};
struct EpiGU {
    static constexpr bool PERM = true; static constexpr int NST = 16;
    bf16* H; const float* ers;
    __device__ __forceinline__ void operator()(const f32x4 (&acc)[2][2][4][2], const Unit& u, int wr, int wc, int fr, int fq) const {
        const int row0 = u.x0 + wr * 64 + fr, col0 = u.pn * 128 + wc * 16 + 4 * fq;
        float rsv[2][4];
#pragma unroll
        for (int ai = 0; ai < 2; ++ai)
#pragma unroll
            for (int m = 0; m < 4; ++m) { const int r = wr * 64 + fr + ai * 128 + m * 16; rsv[ai][m] = ers[u.x1 + (r < u.pm ? r : u.pm - 1)]; }
#pragma unroll
        for (int ai = 0; ai < 2; ++ai)
#pragma unroll
            for (int m = 0; m < 4; ++m) { bf16* rowp = H + (size_t)(row0 + ai * 128 + m * 16) * DE + col0; const float rs = rsv[ai][m];
#pragma unroll
                for (int bj = 0; bj < 2; ++bj) { const f32x4 g = acc[ai][bj][m][0] * rs, up = acc[ai][bj][m][1] * rs; float h[4];
#pragma unroll
                    for (int j = 0; j < 4; ++j) h[j] = g[j] * __builtin_amdgcn_rcpf(1.0f + __expf(-g[j])) * up[j];
                    u32x2 w; w.x = cvt_pk_bf16(h[0], h[1]); w.y = cvt_pk_bf16(h[2], h[3]);
                    *(GAS u32x2*)(rowp + bj * 64) = w; } }
    }
};
struct EpiDown {
    static constexpr bool PERM = true; static constexpr int NST = 16;
    bf16* Y; const int* elist; const float* ewl; bf16* dummy;
    __device__ __forceinline__ void operator()(const f32x4 (&acc)[2][2][4][2], const Unit& u, int wr, int wc, int fr, int fq) const {
        const int col0 = u.pn * 256 + wc * 32 + 8 * fq;
        int sl[2][4]; float wv[2][4];
#pragma unroll
        for (int ai = 0; ai < 2; ++ai)
#pragma unroll
            for (int m = 0; m < 4; ++m) { const int r = wr * 64 + fr + ai * 128 + m * 16; const int ix = u.x1 + (r < u.pm ? r : u.pm - 1); const int s_ = elist[ix]; sl[ai][m] = r < u.pm ? s_ : -1; wv[ai][m] = ewl[ix]; }
#pragma unroll
        for (int ai = 0; ai < 2; ++ai)
#pragma unroll
            for (int m = 0; m < 4; ++m) { const int slot = sl[ai][m]; const float w = wv[ai][m]; const int r = wr * 64 + fr + ai * 128 + m * 16;
                bf16* rowp = (slot >= 0 ? Y + (size_t)slot * DM : dummy + (size_t)r * DM) + col0;
#pragma unroll
                for (int bj = 0; bj < 2; ++bj) { const f32x4 v0 = acc[ai][bj][m][0] * w, v1 = acc[ai][bj][m][1] * w;
                    u32x4 o; o.x = cvt_pk_bf16(v0[0], v0[1]); o.y = cvt_pk_bf16(v0[2], v0[3]); o.z = cvt_pk_bf16(v1[0], v1[1]); o.w = cvt_pk_bf16(v1[2], v1[3]);
                    __builtin_nontemporal_store(o, (GAS u32x4*)(rowp + bj * 128)); } }
    }
};
struct EpiPle {
    static constexpr bool PERM = true; static constexpr int NST = 16;
    const bf16* H2; bf16* H3; const bf16* PE; const float* bias; const float* rs;
    __device__ __forceinline__ void operator()(const f32x4 (&acc)[2][2][4][2], const Unit& u, int wr, int wc, int fr, int fq) const {
        const int row0 = u.pm * 256 + wr * 64 + fr, col0 = u.pn * 256 + wc * 32 + 8 * fq;
        f32x4 bv[2][2];
#pragma unroll
        for (int bj = 0; bj < 2; ++bj)
#pragma unroll
            for (int n = 0; n < 2; ++n) bv[bj][n] = *(const GAS f32x4*)(bias + col0 + bj * 128 + n * 4);
#pragma unroll
        for (int ai = 0; ai < 2; ++ai) {
            u32x4 hw[4][2], pw[4][2]; float rsv[4];
#pragma unroll
            for (int m = 0; m < 4; ++m) rsv[m] = rs[row0 + ai * 128 + m * 16];
#pragma unroll
            for (int m = 0; m < 4; ++m) { const size_t ro = (size_t)(row0 + ai * 128 + m * 16) * DM + col0;
#pragma unroll
                for (int bj = 0; bj < 2; ++bj) { const size_t o = ro + bj * 128; hw[m][bj] = __builtin_nontemporal_load((const GAS u32x4*)(H2 + o)); pw[m][bj] = __builtin_nontemporal_load((const GAS u32x4*)(PE + o)); } }
            EPI_SCHED_BARRIER;
#pragma unroll
            for (int m = 0; m < 4; ++m) { const size_t ro = (size_t)(row0 + ai * 128 + m * 16) * DM + col0;
#pragma unroll
                for (int bj = 0; bj < 2; ++bj) { const size_t o = ro + bj * 128; const u32x4 h = hw[m][bj], q = pw[m][bj];
                    const f32x4 a0 = acc[ai][bj][m][0] * rsv[m] + bv[bj][0], a1 = acc[ai][bj][m][1] * rsv[m] + bv[bj][1];
                    float r[8];
                    r[0] = bflo(h.x) + bflo(q.x) * __builtin_amdgcn_rcpf(1.0f + __expf(-a0[0])); r[1] = bfhi(h.x) + bfhi(q.x) * __builtin_amdgcn_rcpf(1.0f + __expf(-a0[1]));
                    r[2] = bflo(h.y) + bflo(q.y) * __builtin_amdgcn_rcpf(1.0f + __expf(-a0[2])); r[3] = bfhi(h.y) + bfhi(q.y) * __builtin_amdgcn_rcpf(1.0f + __expf(-a0[3]));
                    r[4] = bflo(h.z) + bflo(q.z) * __builtin_amdgcn_rcpf(1.0f + __expf(-a1[0])); r[5] = bfhi(h.z) + bfhi(q.z) * __builtin_amdgcn_rcpf(1.0f + __expf(-a1[1]));
                    r[6] = bflo(h.w) + bflo(q.w) * __builtin_amdgcn_rcpf(1.0f + __expf(-a1[2])); r[7] = bfhi(h.w) + bfhi(q.w) * __builtin_amdgcn_rcpf(1.0f + __expf(-a1[3]));
                    u32x4 w; w.x = cvt_pk_bf16(r[0], r[1]); w.y = cvt_pk_bf16(r[2], r[3]); w.z = cvt_pk_bf16(r[4], r[5]); w.w = cvt_pk_bf16(r[6], r[7]);
                    *(GAS u32x4*)(H3 + o) = w; } }
            EPI_SCHED_BARRIER;
        }
    }
};

__device__ __forceinline__ void row_load_bf(const bf16* row, int lane, float (&f)[4][8]) {
    const GAS v4u* r4 = (const GAS v4u*)row + lane;
#pragma unroll
    for (int j = 0; j < 4; ++j) { const v4u w = r4[64 * j];
        f[j][0] = bflo(w.x); f[j][1] = bfhi(w.x); f[j][2] = bflo(w.y); f[j][3] = bfhi(w.y); f[j][4] = bflo(w.z); f[j][5] = bfhi(w.z); f[j][6] = bflo(w.w); f[j][7] = bfhi(w.w); }
}
__device__ __forceinline__ void row_load_bf_nt(const bf16* row, int lane, float (&f)[4][8]) {
    const GAS v4u* r4 = (const GAS v4u*)row + lane;
#pragma unroll
    for (int j = 0; j < 4; ++j) { const v4u w = __builtin_nontemporal_load(r4 + 64 * j);
        f[j][0] = bflo(w.x); f[j][1] = bfhi(w.x); f[j][2] = bflo(w.y); f[j][3] = bfhi(w.y); f[j][4] = bflo(w.z); f[j][5] = bfhi(w.z); f[j][6] = bflo(w.w); f[j][7] = bfhi(w.w); }
}
__device__ __forceinline__ void row_ldp(const bf16* row, int lane, v4u (&w)[4]) {
    const GAS v4u* r4 = (const GAS v4u*)row + lane;
#pragma unroll
    for (int j = 0; j < 4; ++j) w[j] = r4[64 * j];
}
__device__ __forceinline__ void row_ldp_nt(const bf16* row, int lane, v4u (&w)[4]) {
    const GAS v4u* r4 = (const GAS v4u*)row + lane;
#pragma unroll
    for (int j = 0; j < 4; ++j) w[j] = __builtin_nontemporal_load(r4 + 64 * j);
}
__device__ __forceinline__ void row_unpack(const v4u (&w)[4], float (&f)[4][8]) {
#pragma unroll
    for (int j = 0; j < 4; ++j) { f[j][0] = bflo(w[j].x); f[j][1] = bfhi(w[j].x); f[j][2] = bflo(w[j].y); f[j][3] = bfhi(w[j].y); f[j][4] = bflo(w[j].z); f[j][5] = bfhi(w[j].z); f[j][6] = bflo(w[j].w); f[j][7] = bfhi(w[j].w); }
}
__device__ __forceinline__ float row_ss_bf(const float (&f)[4][8]) {
    float s = 0.f;
#pragma unroll
    for (int j = 0; j < 4; ++j)
#pragma unroll
        for (int k = 0; k < 8; ++k) s += f[j][k] * f[j][k];
    return wave_sum(s);
}
__device__ __forceinline__ void row_norm_bf_store(const float (&f)[4][8], float ss, const float* gain, bf16* orow, int lane) {
    const float r = 1.0f / sqrtf(ss * (1.f / DM) + EPS);
    GAS v4u* o4 = (GAS v4u*)orow + lane;
#pragma unroll
    for (int j = 0; j < 4; ++j) { const GAS f32x4* g4 = (const GAS f32x4*)(gain + (64 * j + lane) * 8); const f32x4 g0 = g4[0], g1 = g4[1]; v4u o;
        o.x = pk2(f[j][0] * r * g0.x, f[j][1] * r * g0.y); o.y = pk2(f[j][2] * r * g0.z, f[j][3] * r * g0.w);
        o.z = pk2(f[j][4] * r * g1.x, f[j][5] * r * g1.y); o.w = pk2(f[j][6] * r * g1.z, f[j][7] * r * g1.w); o4[64 * j] = o; }
}

template <int WIN>
__device__ __forceinline__ void z_load(const bf16* proj, int tp, int g, int lane, v4u (&w)[WIN]) {
    const int t = 2 * tp + (lane >> 5), c8 = g * PG + (lane & 31) * 8, pos = t & (SEQ - 1);
    const bf16* up = proj + (size_t)t * NIN + 3 * AW + c8;
#pragma unroll
    for (int d = 0; d < WIN; ++d) { const int dd = (d <= pos) ? d : 0; w[d] = *(const GAS v4u*)(up - (size_t)dd * NIN); }
}
template <int WIN>
__device__ __forceinline__ void z_fin(const v4u (&w)[WIN], bf16* Z, int tp, int g, int lane) {
    const int t = 2 * tp + (lane >> 5), c8 = g * PG + (lane & 31) * 8, pos = t & (SEQ - 1);
    float s[8];
#pragma unroll
    for (int j = 0; j < 8; ++j) s[j] = 0.f;
#pragma unroll
    for (int d = 0; d < WIN; ++d) { const float m = (d <= pos) ? 1.f : 0.f;
        s[0] += m * bflo(w[d].x); s[1] += m * bfhi(w[d].x); s[2] += m * bflo(w[d].y); s[3] += m * bfhi(w[d].y); s[4] += m * bflo(w[d].z); s[5] += m * bfhi(w[d].z); s[6] += m * bflo(w[d].w); s[7] += m * bfhi(w[d].w); }
    const int cnt = (pos + 1 < WIN) ? pos + 1 : WIN; const float inv = 1.0f / (float)cnt; v4u o;
    o.x = pk2(s[0] * inv - bflo(w[0].x), s[1] * inv - bfhi(w[0].x)); o.y = pk2(s[2] * inv - bflo(w[0].y), s[3] * inv - bfhi(w[0].y));
    o.z = pk2(s[4] * inv - bflo(w[0].z), s[5] * inv - bfhi(w[0].z)); o.w = pk2(s[6] * inv - bflo(w[0].w), s[7] * inv - bfhi(w[0].w));
    *(GAS v4u*)(Z + (size_t)t * PW + c8) = o;
}
__device__ __forceinline__ void p2_kmean_z(Frame& F) {
    const bf16* proj = WSP(bf16, WS_PROJ); float* kmean = WSP(float, WS_KMEAN);
    LAS float* scr = (LAS float*)F.lds;
    for (int it = F.vcu; it < BATCH * NBLK * NH; it += F.G) {
        const int h = it & 7, blk = (it >> 3) & 31, b = it >> 8;
        const GAS unsigned* src = (const GAS unsigned*)(proj + ((size_t)(b * SEQ + blk * MBLK + F.wave * 32)) * NIN + AW + h * HD) + F.lane;
        float s0 = 0.f, s1 = 0.f;
#pragma unroll
        for (int r = 0; r < 32; ++r) { const unsigned w = src[(size_t)r * (NIN / 2)]; s0 += bflo(w); s1 += bfhi(w); }
        __syncthreads();
        scr[F.wave * 128 + 2 * F.lane] = s0; scr[F.wave * 128 + 2 * F.lane + 1] = s1;
        __syncthreads();
        if (F.tid < 128) { float s = 0.f;
#pragma unroll
            for (int w = 0; w < 8; ++w) s += scr[w * 128 + F.tid];
            kmean[((size_t)(b * NH + h) * NBLK + blk) * HD + F.tid] = s * (1.f / MBLK); }
    }
    __syncthreads();
    const int gw = F.vcu * NWAVES + F.wave, NGW = F.G * NWAVES;
    bf16* Z = WSP(bf16, WS_Z);
    for (int tp = gw; tp < T / 2; tp += NGW) {
        v4u w2[2], w4[4], w8[8], w16[16];
        z_load<2>(proj, tp, 0, F.lane, w2); z_load<4>(proj, tp, 1, F.lane, w4); z_load<8>(proj, tp, 2, F.lane, w8); z_load<16>(proj, tp, 3, F.lane, w16);
        z_fin<2>(w2, Z, tp, 0, F.lane); z_fin<4>(w4, Z, tp, 1, F.lane); z_fin<8>(w8, Z, tp, 2, F.lane); z_fin<16>(w16, Z, tp, 3, F.lane);
    }
}

__device__ __forceinline__ float dot_row(const bf16* krow, const unsigned (&qp)[64]) {
    const GAS v4u* k4 = (const GAS v4u*)krow; float a0 = 0.f, a1 = 0.f;
#pragma unroll
    for (int c = 0; c < 16; ++c) { const v4u w = k4[c];
        a0 += bflo(w.x) * bflo(qp[4 * c]) + bflo(w.y) * bflo(qp[4 * c + 1]) + bflo(w.z) * bflo(qp[4 * c + 2]) + bflo(w.w) * bflo(qp[4 * c + 3]);
        a1 += bfhi(w.x) * bfhi(qp[4 * c]) + bfhi(w.y) * bfhi(qp[4 * c + 1]) + bfhi(w.z) * bfhi(qp[4 * c + 2]) + bfhi(w.w) * bfhi(qp[4 * c + 3]); }
    return a0 + a1;
}
__device__ __forceinline__ void attn_simple(Frame& F) {
    const bf16* proj = WSP(bf16, WS_PROJ); const float* kmean = WSP(float, WS_KMEAN); bf16* MIXB = WSP(bf16, WS_MIX);
    LAS unsigned* qs = (LAS unsigned*)(F.lds + F.wave * 256);
    const int gw = F.vcu * NWAVES + F.wave, NGW = F.G * NWAVES, lane = F.lane;
    const float scale = 0.08838834764831845f;
    for (int item = gw; item < T * NH; item += NGW) {
        const int h = item & 7, t = item >> 3, b = t >> 13, qpos = t & (SEQ - 1), own = qpos >> 8;
        const float slope = __builtin_bit_cast(float, (unsigned)(127 - (h + 1)) << 23);
        qs[lane] = ((const GAS unsigned*)(proj + (size_t)t * NIN + h * HD))[lane];
        LDS_WAIT();
        unsigned qp[64];
#pragma unroll
        for (int c = 0; c < 16; ++c) { const v4u w = *(const LAS v4u*)(qs + 4 * c); qp[4 * c] = w.x; qp[4 * c + 1] = w.y; qp[4 * c + 2] = w.z; qp[4 * c + 3] = w.w; }
        LDS_WAIT();
        float gate = -INFINITY;
        if (lane < own) { const GAS f32x4* km = (const GAS f32x4*)(kmean + ((size_t)(b * NH + h) * NBLK + lane) * HD); float a = 0.f;
#pragma unroll
            for (int c = 0; c < 32; ++c) { const f32x4 kv = km[c]; a += kv.x * bflo(qp[2 * c]) + kv.y * bfhi(qp[2 * c]) + kv.z * bflo(qp[2 * c + 1]) + kv.w * bfhi(qp[2 * c + 1]); }
            gate = a; }
        int sel[3] = {0, 0, 0};
#pragma unroll
        for (int r = 0; r < 3; ++r) if (r < own) { const float m = wave_max(gate); const unsigned long long bal = __ballot(gate == m); const int s = __ffsll((long long)bal) - 1; sel[r] = s; if (lane == s) gate = -INFINITY; }
        float sc[4][4];
#pragma unroll
        for (int s = 0; s < 4; ++s) { const bool valid = (s == 3) || (s < own); const int blk = (s == 3) ? own : sel[s];
#pragma unroll
            for (int i = 0; i < 4; ++i) { const int kpos = blk * MBLK + lane + 64 * i; float v = -INFINITY;
                if (valid) { const float d = dot_row(proj + (size_t)(b * SEQ + kpos) * NIN + AW + h * HD, qp); v = d * scale - slope * (float)(qpos - kpos); if (s == 3 && kpos > qpos) v = -INFINITY; }
                sc[s][i] = v; } }
        float mx = -INFINITY;
#pragma unroll
        for (int s = 0; s < 4; ++s)
#pragma unroll
            for (int i = 0; i < 4; ++i) mx = fmaxf(mx, sc[s][i]);
        mx = wave_max(mx);
        float ls = 0.f;
#pragma unroll
        for (int s = 0; s < 4; ++s)
#pragma unroll
            for (int i = 0; i < 4; ++i) { sc[s][i] = __expf(sc[s][i] - mx); ls += sc[s][i]; }
        ls = wave_sum(ls);
        float o0 = 0.f, o1 = 0.f;
#pragma unroll
        for (int s = 0; s < 4; ++s) { const bool valid = (s == 3) || (s < own); const int blk = (s == 3) ? own : sel[s];
            if (valid) {
#pragma unroll
                for (int i = 0; i < 4; ++i) { const GAS unsigned* vb = (const GAS unsigned*)(proj + (size_t)(b * SEQ + blk * MBLK + 64 * i) * NIN + 2 * AW + h * HD) + lane;
#pragma unroll 8
                    for (int kk = 0; kk < 64; ++kk) { const float pk = __builtin_bit_cast(float, __builtin_amdgcn_readlane(__builtin_bit_cast(int, sc[s][i]), kk));
                        const unsigned w = vb[(size_t)kk * (NIN / 2)]; o0 += pk * bflo(w); o1 += pk * bfhi(w); } } } }
        const float il = 1.0f / ls;
        ((GAS unsigned*)(MIXB + (size_t)t * DM + h * HD))[lane] = pk2(o0 * il, o1 * il);
    }
}

__device__ __forceinline__ void p4_mix_norm(Frame& F) {
    bf16* MIXB = WSP(bf16, WS_MIX); const bf16* OP = (const bf16*)F.out; const float* ML = (const float*)(F.ws + (1052u << 20));
    const int gw = F.vcu * NWAVES + F.wave, NGW = F.G * NWAVES, lane = F.lane, h = lane >> 3, sub = lane & 7;
    float gbv[16]; { const float* gb = F.beta_attn + h * HD + 4 * sub;
#pragma unroll
      for (int i = 0; i < 16; ++i) gbv[i] = gb[32 * (i & 3) + (i >> 2)]; }
    f32x4 gpv[4];
#pragma unroll
    for (int j = 0; j < 2; ++j) { const float* gp = F.pool_scale + (64 * j + lane) * 8; gpv[2 * j] = *(const GAS f32x4*)gp; gpv[2 * j + 1] = *(const GAS f32x4*)(gp + 4); }
    v4u pa[4][2], npa[4][2]; f32x4 ml0, ml1, nml0, nml1; v4u pw0, pw1, npw0, npw1;
#define MIX_LOAD(mm, PA, M0, M1, W0, W1) do { const size_t rec_ = (size_t)(mm) * NH + h; \
        _Pragma("unroll") for (int k = 0; k < 4; ++k) { const GAS v4u* src = (const GAS v4u*)(OP + (rec_ * 4 + k) * HD + sub * 16); PA[k][0] = __builtin_nontemporal_load(src); PA[k][1] = __builtin_nontemporal_load(src + 1); }     \
        const GAS f32x4* mlp = (const GAS f32x4*)(ML + rec_ * 8); M0 = __builtin_nontemporal_load(mlp); M1 = __builtin_nontemporal_load(mlp + 1);         \
        const GAS v4u* pr_ = (const GAS v4u*)(MIXB + (size_t)(mm) * DM + AW) + lane; W0 = pr_[0]; W1 = pr_[64]; } while (0)
    MIX_LOAD(gw, pa, ml0, ml1, pw0, pw1); VM_WAIT();
    for (int m = gw; m < T; m += NGW) {
        const int blk = (m & (SEQ - 1)) >> 8, nv = blk < 3 ? blk : 3;
        { const int mn = (m + NGW < T) ? m + NGW : m; MIX_LOAD(mn, npa, nml0, nml1, npw0, npw1); }
        GAS v4u* prow = (GAS v4u*)(MIXB + (size_t)m * DM + AW) + lane;
        const float mk[4] = {nv > 0 ? ml0.x : -1e30f, nv > 1 ? ml0.z : -1e30f, nv > 2 ? ml1.x : -1e30f, ml1.z};
        const float lk[4] = {nv > 0 ? ml0.y : 0.f, nv > 1 ? ml0.w : 0.f, nv > 2 ? ml1.y : 0.f, ml1.w};
        const float M = fmaxf(fmaxf(mk[0], mk[1]), fmaxf(mk[2], mk[3]));
        float e[4]; float L = 0.f;
#pragma unroll
        for (int k = 0; k < 4; ++k) { e[k] = lk[k] * __builtin_amdgcn_exp2f(mk[k] - M); L += e[k]; }
        const float iL = 1.0f / L;
        float f[16];
#pragma unroll
        for (int i = 0; i < 16; ++i) f[i] = 0.f;
#pragma unroll
        for (int k = 0; k < 4; ++k) { const bool ok = (k == 3) || (k < nv); const float w = e[k] * iL;
#pragma unroll
            for (int q = 0; q < 2; ++q) { const v4u x = pa[k][q]; const unsigned x0 = ok ? x.x : 0u, x1 = ok ? x.y : 0u, x2 = ok ? x.z : 0u, x3 = ok ? x.w : 0u;
                f[8 * q + 0] += w * bflo(x0); f[8 * q + 1] += w * bfhi(x0); f[8 * q + 2] += w * bflo(x1); f[8 * q + 3] += w * bfhi(x1);
                f[8 * q + 4] += w * bflo(x2); f[8 * q + 5] += w * bfhi(x2); f[8 * q + 6] += w * bflo(x3); f[8 * q + 7] += w * bfhi(x3); } }
        float ssa = 0.f;
#pragma unroll
        for (int i = 0; i < 16; ++i) { f[i] = bflo(f2bf(f[i]) ); ssa += f[i] * f[i]; }
        float pf[2][8]; float ssp = 0.f;
        { const v4u w[2] = {pw0, pw1};
#pragma unroll
          for (int j = 0; j < 2; ++j) { pf[j][0] = bflo(w[j].x); pf[j][1] = bfhi(w[j].x); pf[j][2] = bflo(w[j].y); pf[j][3] = bfhi(w[j].y); pf[j][4] = bflo(w[j].z); pf[j][5] = bfhi(w[j].z); pf[j][6] = bflo(w[j].w); pf[j][7] = bfhi(w[j].w);
#pragma unroll
              for (int k = 0; k < 8; ++k) ssp += pf[j][k] * pf[j][k]; } }
        ssa = wave_sum(ssa); ssp = wave_sum(ssp);
        const float ra = 1.0f / sqrtf(ssa * (1.f / AW) + EPS), rp = 1.0f / sqrtf(ssp * (1.f / PW) + EPS);
        { float o[16];
#pragma unroll
          for (int i = 0; i < 16; ++i) o[i] = f[i] * ra * gbv[i];
          GAS v4u* dst = (GAS v4u*)(MIXB + (size_t)m * DM + h * HD + sub * 16); v4u o0, o1;
          o0.x = pk2(o[0], o[1]); o0.y = pk2(o[2], o[3]); o0.z = pk2(o[4], o[5]); o0.w = pk2(o[6], o[7]); o1.x = pk2(o[8], o[9]); o1.y = pk2(o[10], o[11]); o1.z = pk2(o[12], o[13]); o1.w = pk2(o[14], o[15]);
          dst[0] = o0; dst[1] = o1; }
#pragma unroll
        for (int j = 0; j < 2; ++j) { const f32x4 g0 = gpv[2 * j], g1 = gpv[2 * j + 1]; v4u o;
            o.x = pk2(pf[j][0] * rp * g0.x, pf[j][1] * rp * g0.y); o.y = pk2(pf[j][2] * rp * g0.z, pf[j][3] * rp * g0.w);
            o.z = pk2(pf[j][4] * rp * g1.x, pf[j][5] * rp * g1.y); o.w = pk2(pf[j][6] * rp * g1.z, pf[j][7] * rp * g1.w);
            prow[64 * j] = o; }
#pragma unroll
        for (int k = 0; k < 4; ++k) { pa[k][0] = npa[k][0]; pa[k][1] = npa[k][1]; }
        ml0 = nml0; ml1 = nml1; pw0 = npw0; pw1 = npw1;
    }
#undef MIX_LOAD
}

__device__ __forceinline__ void gain_load(const float* gain, int lane, f32x4 (&g)[8]) {
#pragma unroll
    for (int j = 0; j < 4; ++j) { const GAS f32x4* g4 = (const GAS f32x4*)(gain + (64 * j + lane) * 8); g[2 * j] = g4[0]; g[2 * j + 1] = g4[1]; }
}
__device__ __forceinline__ void row_norm_bf_store_g(const float (&f)[4][8], float ss, const f32x4 (&g)[8], bf16* orow, int lane) {
    const float r = 1.0f / sqrtf(ss * (1.f / DM) + EPS);
    GAS v4u* o4 = (GAS v4u*)orow + lane;
#pragma unroll
    for (int j = 0; j < 4; ++j) { const f32x4 g0 = g[2 * j], g1 = g[2 * j + 1]; v4u o;
        o.x = pk2(f[j][0] * r * g0.x, f[j][1] * r * g0.y); o.y = pk2(f[j][2] * r * g0.z, f[j][3] * r * g0.w);
        o.z = pk2(f[j][4] * r * g1.x, f[j][5] * r * g1.y); o.w = pk2(f[j][6] * r * g1.z, f[j][7] * r * g1.w); o4[64 * j] = o; }
}
__device__ __forceinline__ void p6_norm_f(Frame& F) {
    const int gw = F.vcu * NWAVES + F.wave, NGW = F.G * NWAVES; const bf16* HB = (const bf16*)F.out; float* rsf = WSP(float, WS_RSF);
    v4u cur[4]; row_ldp(HB + (size_t)gw * DM, F.lane, cur); VM_WAIT();
    for (int m = gw; m < T; m += NGW) { const int mn = (m + NGW < T) ? m + NGW : m; v4u nx[4]; row_ldp(HB + (size_t)mn * DM, F.lane, nx);
        float f[4][8]; row_unpack(cur, f); const float ss = row_ss_bf(f); if (F.lane == 0) rsf[m] = 1.0f / sqrtf(ss * (1.f / DM) + EPS);
#pragma unroll
        for (int j = 0; j < 4; ++j) cur[j] = nx[j]; }
}

__device__ __forceinline__ void p8_route(Frame& F) {
    const float* LG = WSP(float, WS_LOGIT); int* elist = (int*)(F.ws + WS_ROUTE + RT_ELIST); float* ewl = (float*)(F.ws + WS_ROUTE + RT_EWL);
    LAS unsigned* hist = (LAS unsigned*)(F.lds); LAS unsigned* ebase = hist + 64;
    constexpr int CH = NWAVES * 64;
    for (int c0 = F.vcu * CH; c0 < T; c0 += F.G * CH) {
        __syncthreads();
        if (F.tid < 64) hist[F.tid] = 0u;
        __syncthreads();
        const int t = c0 + F.tid;
        const float* l = LG + (size_t)t * 128; const float* l2 = l + (size_t)T * 128;
        float rs; { const float* sq = WSP(float, WS_SSQ) + t; float a0 = 0.f, a1 = 0.f, a2 = 0.f, a3 = 0.f;
#pragma unroll
          for (int k = 0; k < 32; k += 4) { a0 += sq[(size_t)k * T]; a1 += sq[(size_t)(k + 1) * T]; a2 += sq[(size_t)(k + 2) * T]; a3 += sq[(size_t)(k + 3) * T]; }
          rs = 1.0f / sqrtf(((a0 + a1) + (a2 + a3)) * (1.f / DM) + EPS); }
        float lg[8]; float gm = -INFINITY; int gi = 0;
#pragma unroll
        for (int j = 0; j < 8; ++j) { lg[j] = (l[j] + l2[j]) * rs + F.b_rg[j]; if (lg[j] > gm) { gm = lg[j]; gi = j; } }
        float gs = 0.f;
#pragma unroll
        for (int j = 0; j < 8; ++j) gs += __expf(lg[j] - gm);
        const float gval = 1.0f / gs;
        float le[8]; float em = -INFINITY;
#pragma unroll
        for (int j = 0; j < 8; ++j) { le[j] = (l[8 + gi * 8 + j] + l2[8 + gi * 8 + j]) * rs + F.b_re[gi * 8 + j]; em = fmaxf(em, le[j]); }
        float es = 0.f;
#pragma unroll
        for (int j = 0; j < 8; ++j) { le[j] = __expf(le[j] - em); es += le[j]; }
        float v1 = -1.f, v2 = -1.f; int i1 = 0, i2 = 0;
#pragma unroll
        for (int j = 0; j < 8; ++j) { const float pv = le[j] / es; if (pv > v1) { v2 = v1; i2 = i1; v1 = pv; i1 = j; } else if (pv > v2) { v2 = pv; i2 = j; } }
        const float inv = 1.0f / (v1 + v2);
        const int e1 = gi * 8 + i1, e2 = gi * 8 + i2;
        const unsigned r1 = __hip_atomic_fetch_add(hist + e1, 1u, __ATOMIC_RELAXED, __HIP_MEMORY_SCOPE_WORKGROUP), r2 = __hip_atomic_fetch_add(hist + e2, 1u, __ATOMIC_RELAXED, __HIP_MEMORY_SCOPE_WORKGROUP);
        __syncthreads();
        if (F.tid < 64) { const unsigned c = hist[F.tid]; ebase[F.tid] = c ? atomicAdd((unsigned*)(F.ctl + CW_ECNT + F.tid), c) : 0u; }
        __syncthreads();
        const int k1 = (int)(ebase[e1] + r1), k2 = (int)(ebase[e2] + r2);
        elist[e1 * T + k1] = 2 * t; ewl[e1 * T + k1] = gval * (v1 * inv); elist[e2 * T + k2] = 2 * t + 1; ewl[e2 * T + k2] = gval * (v2 * inv);
        { float* ers = WSP(float, WS_ERS); ers[e1 * T + k1] = rs; ers[e2 * T + k2] = rs; }
    }
    __syncthreads();
}
__device__ __forceinline__ void p12_combine(Frame& F) {
    const bf16* Y = WSP(bf16, WS_PROJ); bf16* HB = (bf16*)F.out;
    const int gw = F.vcu * NWAVES + F.wave, NGW = F.G * NWAVES, lane = F.lane;
    v4u cf[4], c0[4], c1[4]; row_ldp_nt(HB + (size_t)gw * DM, lane, cf); row_ldp_nt(Y + (size_t)(2 * gw) * DM, lane, c0); row_ldp_nt(Y + (size_t)(2 * gw + 1) * DM, lane, c1); VM_WAIT();
    for (int m = gw; m < T; m += NGW) { const int mn = (m + NGW < T) ? m + NGW : m; bf16* hrow = HB + (size_t)m * DM;
        v4u nf[4], n0[4], n1[4]; row_ldp_nt(HB + (size_t)mn * DM, lane, nf); row_ldp_nt(Y + (size_t)(2 * mn) * DM, lane, n0); row_ldp_nt(Y + (size_t)(2 * mn + 1) * DM, lane, n1);
        float f[4][8], y0[4][8], y1[4][8]; row_unpack(cf, f); row_unpack(c0, y0); row_unpack(c1, y1);
        GAS v4u* o4 = (GAS v4u*)hrow + lane;
#pragma unroll
        for (int j = 0; j < 4; ++j) {
#pragma unroll
            for (int k = 0; k < 8; ++k) f[j][k] += y0[j][k] + y1[j][k];
            v4u o; o.x = pk2(f[j][0], f[j][1]); o.y = pk2(f[j][2], f[j][3]); o.z = pk2(f[j][4], f[j][5]); o.w = pk2(f[j][6], f[j][7]); o4[64 * j] = o; }
        const float ss = row_ss_bf(f); if (lane == 0) WSP(float, WS_RS3)[m] = 1.0f / sqrtf(ss * (1.f / DM) + EPS);
#pragma unroll
        for (int j = 0; j < 4; ++j) { cf[j] = nf[j]; c0[j] = n0[j]; c1[j] = n1[j]; } }
}
__device__ __forceinline__ void p15_final(Frame& F) {
    const bf16* H3 = WSP(bf16, WS_PROJ);
    const int gw = F.vcu * NWAVES + F.wave, NGW = F.G * NWAVES, lane = F.lane;
    f32x4 gn[8]; gain_load(F.g_final, lane, gn);
    v4u cur[4]; row_ldp_nt(H3 + (size_t)gw * DM, lane, cur); VM_WAIT();
    for (int m = gw; m < T; m += NGW) { const int mn = (m + NGW < T) ? m + NGW : m; v4u nx[4]; row_ldp_nt(H3 + (size_t)mn * DM, lane, nx); float f[4][8]; row_unpack(cur, f); const float ss = row_ss_bf(f);
        const float r = 1.0f / sqrtf(ss * (1.f / DM) + EPS); float* orow = F.out + (size_t)m * DM;
#pragma unroll
        for (int j = 0; j < 4; ++j) { const int col = (64 * j + lane) * 8; const f32x4 g0 = gn[2 * j], g1 = gn[2 * j + 1];
            f32x4 o0, o1; o0.x = f[j][0] * r * g0.x; o0.y = f[j][1] * r * g0.y; o0.z = f[j][2] * r * g0.z; o0.w = f[j][3] * r * g0.w;
            o1.x = f[j][4] * r * g1.x; o1.y = f[j][5] * r * g1.y; o1.z = f[j][6] * r * g1.z; o1.w = f[j][7] * r * g1.w;
            __builtin_nontemporal_store(o0, (GAS f32x4*)(orow + col)); __builtin_nontemporal_store(o1, (GAS f32x4*)(orow + col + 4)); }
#pragma unroll
        for (int j = 0; j < 4; ++j) cur[j] = nx[j]; }
}

constexpr int CW_ACNT = 32768;
constexpr int LISTCAP = SEQ * 31 - MBLK * (31 * 32 / 2);
__host__ __device__ constexpr int list_base(int j) { return SEQ * j - MBLK * (j * (j + 1) / 2); }
constexpr size_t WS_ALIST = 1035 * MiB;
constexpr size_t WS_ML = 1052 * MiB;
constexpr size_t WS_END2 = 1097 * MiB;
constexpr int ATAB_OFF = TAB_OFF;

namespace att {
using bf16x8 = __attribute__((ext_vector_type(8))) short;
using s16x4  = __attribute__((ext_vector_type(4))) short;
using f32x16 = __attribute__((ext_vector_type(16))) float;
using u32x4  = __attribute__((ext_vector_type(4))) unsigned;
constexpr int D = 128, NW = 8, QBLK = 32, KVBLK = 64, LDK = NIN;
constexpr float SCALE = 0.088388347648318440f;
constexpr float THR = 8.f;
constexpr float C = SCALE * 1.4426950408889634f;
constexpr size_t SHM_V = KVBLK * D * 2, SHM_K = KVBLK * D * 2;
constexpr int WS_OFF = 2 * SHM_V + 2 * SHM_K;
#define KSWZ(row, colB) ((row) * 256 + ((colB) ^ (((row) & 7) << 4)))
#define SBAR() __builtin_amdgcn_sched_barrier(0)
__device__ __forceinline__ int crow(int r, int hi) { return (r & 3) + 8 * (r >> 2) + 4 * hi; }
__device__ __forceinline__ unsigned cvtpk(float lo, float hi) { unsigned r; asm volatile("v_cvt_pk_bf16_f32 %0, %1, %2" : "=v"(r) : "v"(lo), "v"(hi)); return r; }

__device__ __forceinline__ void partialSM(f32x16& p0, f32x16& p1, float& m_reg, float& mn, float& alpha) {
  float pmax = p0[0];
#pragma unroll
  for (int r = 1; r < 16; ++r) pmax = fmaxf(pmax, p0[r]);
#pragma unroll
  for (int r = 0; r < 16; ++r) pmax = fmaxf(pmax, p1[r]);
  { auto rr = __builtin_amdgcn_permlane32_swap(__float_as_uint(pmax), __float_as_uint(pmax), false, false);
    pmax = fmaxf(__uint_as_float(rr[0]), __uint_as_float(rr[1])); }
  { const bool keep = (pmax - m_reg <= THR / SCALE); mn = keep ? m_reg : pmax; alpha = keep ? 1.f : __builtin_amdgcn_exp2f((m_reg - mn) * C); m_reg = mn; }
  float mnC = -mn * C;
#pragma unroll
  for (int r = 0; r < 16; ++r) p0[r] = fmaf(p0[r], C, mnC);
#pragma unroll
  for (int r = 0; r < 16; ++r) p1[r] = fmaf(p1[r], C, mnC);
#pragma unroll
  for (int r = 0; r < 16; ++r) p0[r] = __builtin_amdgcn_exp2f(p0[r]);
}
__device__ __forceinline__ void finishSM(f32x16& p0, f32x16& p1, float alpha, float& l_reg, bf16x8& pa0, bf16x8& pa1, bf16x8& pa2, bf16x8& pa3) {
#pragma unroll
  for (int r = 0; r < 16; ++r) p1[r] = __builtin_amdgcn_exp2f(p1[r]);
  float ps = 0;
#pragma unroll
  for (int r = 0; r < 16; ++r) ps += p0[r];
#pragma unroll
  for (int r = 0; r < 16; ++r) ps += p1[r];
  { auto rr = __builtin_amdgcn_permlane32_swap(__float_as_uint(ps), __float_as_uint(ps), false, false);
    ps = __uint_as_float(rr[0]) + __uint_as_float(rr[1]); }
  l_reg = l_reg * alpha + ps;
#define PK4(P, BASE, OUT) do { unsigned a0 = cvtpk(P[BASE + 0], P[BASE + 1]), a1 = cvtpk(P[BASE + 2], P[BASE + 3]);   \
    unsigned b0 = cvtpk(P[BASE + 4], P[BASE + 5]), b1 = cvtpk(P[BASE + 6], P[BASE + 7]);                              \
    auto r0 = __builtin_amdgcn_permlane32_swap(a0, b0, false, false); auto r1 = __builtin_amdgcn_permlane32_swap(a1, b1, false, false); \
    u32x4 w = {r0[0], r1[0], r0[1], r1[1]}; OUT = *reinterpret_cast<bf16x8*>(&w); } while (0)
  PK4(p0, 0, pa0); PK4(p0, 8, pa1); PK4(p1, 0, pa2); PK4(p1, 8, pa3);
#undef PK4
}
template <bool OWN>
__device__ __forceinline__ void qkt(f32x16& p0, f32x16& p1, const char* Ks, const bf16x8* qr, int r32, int hi, float ks, float kbase, int qrel) {
#pragma unroll
  for (int r = 0; r < 16; ++r) { p0[r] = fmaf(ks, (float)((r & 3) + 8 * (r >> 2)), kbase); p1[r] = fmaf(ks, (float)(32 + (r & 3) + 8 * (r >> 2)), kbase); }
#pragma unroll
  for (int d0 = 0; d0 < 8; ++d0) { int cb = (d0 * 16 + hi * 8) * 2;
    bf16x8 b0 = *reinterpret_cast<const bf16x8*>(Ks + KSWZ(r32, cb));
    bf16x8 b1 = *reinterpret_cast<const bf16x8*>(Ks + KSWZ(32 + r32, cb));
    p0 = __builtin_amdgcn_mfma_f32_32x32x16_bf16(b0, qr[d0], p0, 0, 0, 0);
    p1 = __builtin_amdgcn_mfma_f32_32x32x16_bf16(b1, qr[d0], p1, 0, 0, 0); }
  if constexpr (OWN) {
#pragma unroll
    for (int r = 0; r < 16; ++r) { if (((r & 3) + 8 * (r >> 2)) > qrel) p0[r] = -1e30f; if ((32 + (r & 3) + 8 * (r >> 2)) > qrel) p1[r] = -1e30f; }
  }
}
__device__ __forceinline__ int v_st(int k, int c) { const int kk = (k & ~0xC) | ((k & 4) << 1) | ((k & 8) >> 1); return ((kk >> 3) * 4 + (c >> 5)) * 512 + ((kk & 7) * 32 + (c & 31)) * 2; }
__device__ __forceinline__ int v_rd_base(int lane) { return ((lane & 3) << 3) | (((lane >> 2) & 3) << 6) | (((lane >> 4) & 1) << 5) | (((lane >> 5) & 1) << 8); }
constexpr int v_rd_off(int d0, int ks, int half) { return d0 * 512 + ks * 4096 + half * 2048; }
template <int OFF> __device__ __forceinline__ s16x4 tr_read(int vb) {
  s16x4 r; asm volatile("ds_read_b64_tr_b16 %0, %1 offset:%2" : "=&v"(r) : "v"(vb), "i"(OFF) : "memory"); return r;
}
template <int D0> __device__ __forceinline__ void pv_one(f32x16& od, int vb, bf16x8 pa0, bf16x8 pa1, bf16x8 pa2, bf16x8 pa3) {
  const s16x4 l0 = tr_read<v_rd_off(D0, 0, 0)>(vb), h0 = tr_read<v_rd_off(D0, 0, 1)>(vb), l1 = tr_read<v_rd_off(D0, 1, 0)>(vb), h1 = tr_read<v_rd_off(D0, 1, 1)>(vb);
  const s16x4 l2 = tr_read<v_rd_off(D0, 2, 0)>(vb), h2 = tr_read<v_rd_off(D0, 2, 1)>(vb), l3 = tr_read<v_rd_off(D0, 3, 0)>(vb), h3 = tr_read<v_rd_off(D0, 3, 1)>(vb);
  asm volatile("s_waitcnt lgkmcnt(0)" ::: "memory"); SBAR();
#define PK(L, H) (bf16x8){L[0], L[1], L[2], L[3], H[0], H[1], H[2], H[3]}
  od = __builtin_amdgcn_mfma_f32_32x32x16_bf16(pa0, PK(l0, h0), od, 0, 0, 0);
  od = __builtin_amdgcn_mfma_f32_32x32x16_bf16(pa1, PK(l1, h1), od, 0, 0, 0);
  od = __builtin_amdgcn_mfma_f32_32x32x16_bf16(pa2, PK(l2, h2), od, 0, 0, 0);
  od = __builtin_amdgcn_mfma_f32_32x32x16_bf16(pa3, PK(l3, h3), od, 0, 0, 0);
#undef PK
}
__device__ __forceinline__ void pv_d0(f32x16* o, int vb, bf16x8 pa0, bf16x8 pa1, bf16x8 pa2, bf16x8 pa3) {
  pv_one<0>(o[0], vb, pa0, pa1, pa2, pa3); pv_one<1>(o[1], vb, pa0, pa1, pa2, pa3); pv_one<2>(o[2], vb, pa0, pa1, pa2, pa3); pv_one<3>(o[3], vb, pa0, pa1, pa2, pa3);
}

constexpr int KV_K_OFF = 0, KV_V_OFF = 65536, WSCR_OFF = 147456;
__device__ __forceinline__ void kv_load_block(const bf16* __restrict__ proj, int b, int h, int blk, char* lds) {
  const int tid = threadIdx.x, sr = tid >> 4, sc = (tid & 15) * 8;
  const bf16* Kh = proj + ((size_t)b * SEQ + (size_t)blk * MBLK) * NIN + AW + h * HD;
  const bf16* Vh = Kh + AW;
  bf16x8 kr[8], vr[8];
#pragma unroll
  for (int i = 0; i < 8; ++i) { kr[i] = *reinterpret_cast<const bf16x8*>(&Kh[(size_t)(sr + 32 * i) * LDK + sc]); vr[i] = *reinterpret_cast<const bf16x8*>(&Vh[(size_t)(sr + 32 * i) * LDK + sc]); }
  __syncthreads();
#pragma unroll
  for (int i = 0; i < 8; ++i) { const int row = sr + 32 * i, kt = row >> 6, r = row & 63;
    *(bf16x8*)(lds + KV_K_OFF + kt * 16384 + KSWZ(r, sc * 2)) = kr[i];
    *(bf16x8*)(lds + KV_V_OFF + kt * 16384 + v_st(r, sc)) = vr[i]; }
  __syncthreads();
}
__device__ __forceinline__ void ld_q(const bf16* __restrict__ proj, int b, int h, int qpos, int hi, bf16x8 (&qr)[8]) {
  const bf16* Qw = proj + ((size_t)b * SEQ + qpos) * NIN + h * HD + hi * 8;
#pragma unroll
  for (int d0 = 0; d0 < 8; ++d0) qr[d0] = *reinterpret_cast<const bf16x8*>(Qw + d0 * 16);
}
template <bool OWN, int NT>
__device__ __forceinline__ void wave_group(int b, int h, int blk, int g, int qpos, int rank, bool valid, const bf16x8 (&qr)[8],
                                           bf16* __restrict__ OP, float* __restrict__ ML, char* lds) {
  const int tid = threadIdx.x, wid = tid >> 6; int lane = tid & 63;
  asm volatile("" : "+v"(lane));
  const int r32 = lane & 31, hi = lane >> 5;
  const char* K_lds = lds + KV_K_OFF;
  float* ws = (float*)(lds + WSCR_OFF) + wid * 256;
  float* li_l = ws; float* al_l = ws + 32; int* dst_l = (int*)(ws + 128);
  const float slope = __builtin_bit_cast(float, (unsigned)(127 - (h + 1)) << 23);
  const float ks = slope * (1.0f / SCALE);
  const int qi = g * QBLK + r32;
  const size_t tok = (size_t)b * SEQ + qpos;
  float m_reg = -1e30f, l_reg = 0; f32x16 o[4] = {};
  const int vb0 = (int)(uintptr_t)(lds + KV_V_OFF) + v_rd_base(lane);
#define RESC(a) do { if (__any((a) < 1.f)) { if (hi == 0) al_l[r32] = (a); asm volatile("s_waitcnt lgkmcnt(0)" ::: "memory"); \
    _Pragma("unroll") for (int d = 0; d < 4; ++d) _Pragma("unroll") for (int r = 0; r < 16; ++r) o[d][r] *= al_l[crow(r, hi)]; } } while (0)
#define KBASE(kt) (ks * (float)((kt) * 64 + 4 * hi))
#define QREL(kt) (qi - 64 * (kt) - 4 * hi)
  bf16x8 pa0, pa1, pa2, pa3;
  {
    f32x16 pA0, pA1, pB0, pB1; float mnA, mnB, alA, alB;
#define QK(P0, P1, t) qkt<OWN>(P0, P1, K_lds + (t) * 16384, qr, r32, hi, ks, KBASE(t), QREL(t))
#define PV(t) pv_d0(o, vb0 + (t) * 16384, pa0, pa1, pa2, pa3)
    QK(pA0, pA1, NT - 1); partialSM(pA0, pA1, m_reg, mnA, alA);
    if constexpr (NT >= 2) {
      SBAR(); QK(pB0, pB1, NT - 2); finishSM(pA0, pA1, alA, l_reg, pa0, pa1, pa2, pa3); SBAR(); PV(NT - 1); partialSM(pB0, pB1, m_reg, mnB, alB); RESC(alB);
      if constexpr (NT >= 3) {
        SBAR(); QK(pA0, pA1, NT - 3); finishSM(pB0, pB1, alB, l_reg, pa0, pa1, pa2, pa3); SBAR(); PV(NT - 2); partialSM(pA0, pA1, m_reg, mnA, alA); RESC(alA);
        if constexpr (NT >= 4) {
          SBAR(); QK(pB0, pB1, NT - 4); finishSM(pA0, pA1, alA, l_reg, pa0, pa1, pa2, pa3); SBAR(); PV(NT - 3); partialSM(pB0, pB1, m_reg, mnB, alB); RESC(alB);
          finishSM(pB0, pB1, alB, l_reg, pa0, pa1, pa2, pa3); SBAR(); PV(0);
        } else { finishSM(pA0, pA1, alA, l_reg, pa0, pa1, pa2, pa3); SBAR(); PV(0); }
      } else { finishSM(pB0, pB1, alB, l_reg, pa0, pa1, pa2, pa3); SBAR(); PV(0); }
    } else { finishSM(pA0, pA1, alA, l_reg, pa0, pa1, pa2, pa3); SBAR(); PV(0); }
#undef QK
#undef PV
  }
  const float mlog = m_reg * C + 1.4426950408889634f * slope * (float)(blk * MBLK - qpos);
  {
    const int dst = valid ? (int)((tok * NH + h) * 4 + (OWN ? 3 : rank)) : -1;
    if (hi == 0) { li_l[r32] = l_reg; dst_l[r32] = dst; if (valid) { v2u t; t.x = __builtin_bit_cast(unsigned, mlog); t.y = __builtin_bit_cast(unsigned, l_reg); *(GAS v2u*)(ML + 2 * (size_t)dst) = t; } }
    asm volatile("s_waitcnt lgkmcnt(0)" ::: "memory");
#pragma unroll
    for (int r = 0; r < 16; ++r) { const int row = crow(r, hi); const float il = __builtin_amdgcn_rcpf(li_l[row]); const int d = dst_l[row];
      if (d >= 0) { v2u w; w.x = cvtpk(o[0][r] * il, o[1][r] * il); w.y = cvtpk(o[2][r] * il, o[3][r] * il); *(GAS v2u*)(OP + (size_t)d * HD + r32 * 4) = w; } }
  }
  asm volatile("s_waitcnt lgkmcnt(0)" ::: "memory");
#undef RESC
#undef KBASE
#undef QREL
}
#undef KSWZ
#undef SBAR
}

__device__ __forceinline__ void top3_insert(float g, int idx, float& v1, float& v2, float& v3, int& i1, int& i2, int& i3) {
    if (g > v1) { v3 = v2; i3 = i2; v2 = v1; i2 = i1; v1 = g; i1 = idx; } else if (g > v2) { v3 = v2; i3 = i2; v2 = g; i2 = idx; } else if (g > v3) { v3 = g; i3 = idx; }
}
__device__ __forceinline__ bool gate_before(float va, int ia, float vb, int ib) { return va > vb || (va == vb && ia < ib); }
#define GSWZ(row, colB) ((row) * 256 + ((colB) ^ (((row) & 7) << 4)))
__device__ __forceinline__ void gate_set(const bf16* __restrict__ proj, int b, int h, int qrow, int own, const char* khi, const char* klo, int r32, int hi,
                                         float& v1, float& v2, float& v3, int& i1, int& i2, int& i3) {
    att::bf16x8 q[8]; att::ld_q(proj, b, h, qrow, hi, q);
    att::f32x16 g = {};
#pragma unroll
    for (int d0 = 0; d0 < 8; ++d0) { const int cb = (d0 * 16 + hi * 8) * 2;
        const att::bf16x8 ah = *reinterpret_cast<const att::bf16x8*>(khi + GSWZ(r32, cb)), al = *reinterpret_cast<const att::bf16x8*>(klo + GSWZ(r32, cb));
        g = __builtin_amdgcn_mfma_f32_32x32x16_bf16(ah, q[d0], g, 0, 0, 0); g = __builtin_amdgcn_mfma_f32_32x32x16_bf16(al, q[d0], g, 0, 0, 0); }
    float w1 = -INFINITY, w2 = -INFINITY, w3 = -INFINITY; int j1 = 0, j2 = 0, j3 = 0;
#pragma unroll
    for (int r = 0; r < 16; ++r) { const int idx = (r & 3) + 8 * (r >> 2) + 4 * hi; const float gv = (idx < own) ? g[r] : -INFINITY;
        const bool b1 = gv > w1, b2 = gv > w2, b3 = gv > w3;
        const float n3 = b2 ? w2 : (b3 ? gv : w3); const int m3 = b2 ? j2 : (b3 ? idx : j3);
        const float n2 = b1 ? w1 : (b2 ? gv : w2); const int m2 = b1 ? j1 : (b2 ? idx : j2);
        const float n1 = b1 ? gv : w1;             const int m1 = b1 ? idx : j1;
        w1 = n1; w2 = n2; w3 = n3; j1 = m1; j2 = m2; j3 = m3; }
    v1 = w1; v2 = w2; v3 = w3; i1 = j1; i2 = j2; i3 = j3;
}
__device__ __forceinline__ void attn_gate_lists(Frame& F, const bool dummy = false) {
    const bf16* proj = WSP(bf16, WS_PROJ); const float* kmean = WSP(float, WS_KMEAN); unsigned* alist = dummy ? WSP(unsigned, WS_Z) : WSP(unsigned, WS_ALIST);
    const int cw_acnt = dummy ? 65536 : CW_ACNT;
    char* khi = (char*)F.ldsg; char* klo = khi + 8192;
    LAS unsigned* ghist = (LAS unsigned*)(F.lds + ATAB_OFF);
    const int lane = F.lane, r32 = lane & 31, hi = lane >> 5;
    for (int it = F.vcu; it < BATCH * NH * (SEQ / 512); it += F.G) {
        const int i2 = it & 15, h = (it >> 4) & 7, b = it >> 7;
        __syncthreads();
        { const int row = F.tid >> 4, c8 = (F.tid & 15) * 8; const GAS f32x4* src = (const GAS f32x4*)(kmean + ((size_t)(b * NH + h) * NBLK + row) * HD + c8); const f32x4 x0 = src[0], x1 = src[1];
          v4u hw, lw; hw.x = pk2(x0.x, x0.y); hw.y = pk2(x0.z, x0.w); hw.z = pk2(x1.x, x1.y); hw.w = pk2(x1.z, x1.w);
          lw.x = pk2(x0.x - bflo(hw.x), x0.y - bfhi(hw.x)); lw.y = pk2(x0.z - bflo(hw.y), x0.w - bfhi(hw.y)); lw.z = pk2(x1.x - bflo(hw.z), x1.y - bfhi(hw.z)); lw.w = pk2(x1.z - bflo(hw.w), x1.w - bfhi(hw.w));
          *(v4u*)(khi + GSWZ(row, c8 * 2)) = hw; *(v4u*)(klo + GSWZ(row, c8 * 2)) = lw; if (F.tid < 32) ghist[F.tid] = 0u; }
        __syncthreads();
        const int qbase = i2 * 512 + F.wave * 64, own = qbase >> 8;
        const int qpos = qbase + lane;
        int s0 = -1, s1i = -1, s2i = -1, off0 = 0, off1 = 0, off2 = 0; unsigned wb = 0;
        if (own > 0) {
            float a1, a2, a3, c1, c2, c3; int ia1, ia2, ia3, ic1, ic2, ic3;
            gate_set(proj, b, h, qbase + r32, own, khi, klo, r32, hi, a1, a2, a3, ia1, ia2, ia3);
            gate_set(proj, b, h, qbase + 32 + r32, own, khi, klo, r32, hi, c1, c2, c3, ic1, ic2, ic3);
            float v1 = hi ? c1 : a1, v2 = hi ? c2 : a2, v3 = hi ? c3 : a3; int i1 = hi ? ic1 : ia1, i2s = hi ? ic2 : ia2, i3 = hi ? ic3 : ia3;
            { const float s1 = hi ? a1 : c1, s2 = hi ? a2 : c2, s3 = hi ? a3 : c3; const int t1 = hi ? ia1 : ic1, t2 = hi ? ia2 : ic2, t3 = hi ? ia3 : ic3;
              const float p1 = __shfl_xor(s1, 32), p2 = __shfl_xor(s2, 32), p3 = __shfl_xor(s3, 32); const int u1 = __shfl_xor(t1, 32), u2 = __shfl_xor(t2, 32), u3 = __shfl_xor(t3, 32);
#define GINS(pv, pi) do { if (gate_before(pv, pi, v1, i1)) { v3 = v2; i3 = i2s; v2 = v1; i2s = i1; v1 = pv; i1 = pi; } else if (gate_before(pv, pi, v2, i2s)) { v3 = v2; i3 = i2s; v2 = pv; i2s = pi; } \
                  else if (gate_before(pv, pi, v3, i3)) { v3 = pv; i3 = pi; } } while (0)
              GINS(p1, u1); GINS(p2, u2); GINS(p3, u3);
#undef GINS
            }
            (void)v1; (void)v2; (void)v3;
            const int nv = own < 3 ? own : 3;
            s0 = i1; s1i = nv > 1 ? i2s : -1; s2i = nv > 2 ? i3 : -1;
            int mycnt = 0;
            const unsigned long long lt = (1ull << lane) - 1ull;
            for (int j = 0; j < own; ++j) {
                const bool mine = (s0 == j) || (s1i == j) || (s2i == j);
                const unsigned long long bal = __ballot(mine);
                const int cw = __popcll(bal), of = __popcll(bal & lt);
                if (lane == j) mycnt = cw;
                if (s0 == j) off0 = of; if (s1i == j) off1 = of; if (s2i == j) off2 = of;
            }
            if (lane < own && mycnt > 0) wb = __hip_atomic_fetch_add(ghist + lane, (unsigned)mycnt, __ATOMIC_RELAXED, __HIP_MEMORY_SCOPE_WORKGROUP);
        }
        __syncthreads();
        if (F.tid < 32) { const unsigned c = ghist[F.tid]; ghist[32 + F.tid] = c ? atomicAdd((unsigned*)(F.ctl + cw_acnt + 16 * ((b * NH + h) * NBLK + F.tid)), c) : 0u; }
        __syncthreads();
        if (own > 0) {
            const unsigned base = ghist[32 + (lane & 31)] + wb;
            const unsigned b0 = (unsigned)__shfl((int)base, s0 < 0 ? 0 : s0), b1 = (unsigned)__shfl((int)base, s1i < 0 ? 0 : s1i), b2 = (unsigned)__shfl((int)base, s2i < 0 ? 0 : s2i);
            unsigned* lb = alist + (size_t)(b * NH + h) * LISTCAP;
            lb[list_base(s0) + b0 + off0] = (unsigned)qpos;
            if (s1i >= 0) lb[list_base(s1i) + b1 + off1] = (unsigned)qpos | (1u << 13);
            if (s2i >= 0) lb[list_base(s2i) + b2 + off2] = (unsigned)qpos | (2u << 13);
        }
    }
#undef GSWZ
}
constexpr int KVCOST = 8;
constexpr int OWNG = 8;
__device__ __forceinline__ void attn_all(Frame& F) {
    const bf16* proj = WSP(bf16, WS_PROJ); const unsigned* alist = WSP(unsigned, WS_ALIST);
    LAS int* pre = (LAS int*)(F.lds + ATAB_OFF);
    __syncthreads();
    { const int t = F.tid; const int n0 = (int)((__hip_atomic_load(F.ctl + CW_ACNT + 16 * (2 * t), RLX_AGENT) + 31u) >> 5), n1 = (int)((__hip_atomic_load(F.ctl + CW_ACNT + 16 * (2 * t + 1), RLX_AGENT) + 31u) >> 5);
      const int c0 = n0 + OWNG + KVCOST, c1 = n1 + OWNG + KVCOST;
      const int s = c0 + c1; int x = s;
#pragma unroll
      for (int o = 1; o < 64; o <<= 1) { const int y = __shfl_up(x, o); if (F.lane >= o) x += y; }
      if (F.lane == 63) pre[1032 + F.wave] = x;
      __syncthreads();
      int woff = 0;
#pragma unroll
      for (int w = 0; w < 8; ++w) woff += (w < F.wave) ? pre[1032 + w] : 0;
      const int excl = woff + x - s;
      pre[2 * t] = excl; pre[2 * t + 1] = excl + c0; if (t == 511) pre[1024] = excl + s; }
    __syncthreads();
    const int CT = pre[1024];
    const int c_lo = (int)(((long)CT * F.vcu) / F.G), c_hi = (int)(((long)CT * (F.vcu + 1)) / F.G);
    int lo = 0, hi = 1023;
    while (lo < hi) { const int mid = (lo + hi + 1) >> 1; if (pre[mid] <= c_lo) lo = mid; else hi = mid - 1; }
    for (int item = lo; item < 1024 && pre[item] < c_hi; ++item) {
        const int ngi = pre[item + 1] - pre[item] - KVCOST;
        int g_lo = c_lo - pre[item] - KVCOST, g_hi = c_hi - pre[item] - KVCOST;
        g_lo = g_lo < 0 ? 0 : g_lo; g_hi = g_hi > ngi ? ngi : g_hi;
        if (g_lo >= g_hi) continue;
        const int j = item & 31, bh = item >> 5, h = bh & 7, b = bh >> 3, nsel = ngi - OWNG;
        const int cnt = (int)__hip_atomic_load(F.ctl + CW_ACNT + 16 * item, RLX_AGENT);
        att::kv_load_block(proj, b, h, j, (char*)F.ldsg);
        const unsigned* lst = alist + (size_t)bh * LISTCAP + list_base(j);
        { const int r32 = F.lane & 31, hi2 = F.lane >> 5;
          for (int gi = g_lo + F.wave; gi < g_hi; gi += NWAVES) {
              if (gi < nsel) {
                  const bool valid = gi * 32 + r32 < cnt; const unsigned e = lst[gi * 32 + (valid ? r32 : 0)]; att::bf16x8 q[8];
                  att::ld_q(proj, b, h, (int)(e & 8191u), hi2, q);
                  att::wave_group<false, 4>(b, h, j, gi, (int)(e & 8191u), (int)(e >> 13), valid, q, (bf16*)F.out, WSP(float, WS_ML), (char*)F.ldsg);
              } else {
                  const int g = gi - nsel, qpos = j * MBLK + g * 32 + r32; att::bf16x8 q[8]; att::ld_q(proj, b, h, qpos, hi2, q);
                  switch (g >> 1) {
                    case 0: att::wave_group<true, 1>(b, h, j, g, qpos, 3, true, q, (bf16*)F.out, WSP(float, WS_ML), (char*)F.ldsg); break;
                    case 1: att::wave_group<true, 2>(b, h, j, g, qpos, 3, true, q, (bf16*)F.out, WSP(float, WS_ML), (char*)F.ldsg); break;
                    case 2: att::wave_group<true, 3>(b, h, j, g, qpos, 3, true, q, (bf16*)F.out, WSP(float, WS_ML), (char*)F.ldsg); break;
                    default: att::wave_group<true, 4>(b, h, j, g, qpos, 3, true, q, (bf16*)F.out, WSP(float, WS_ML), (char*)F.ldsg); break; }
              }
          } }
    }
    __syncthreads();
}

#ifndef STAG16
#define STAG16 0
#endif
#ifndef STAG7
#define STAG7 0
#endif
#ifndef P1_NC
#define P1_NC 128
#define P1_K1 6
#endif
#ifndef MK_N_LAUNCHES
#define MK_N_LAUNCHES 1
#endif
constexpr int NPHASES = 18;
#ifndef PROBE_DUP
#define PROBE_DUP (-1)
#endif

constexpr int N_LAUNCHES = MK_N_LAUNCHES;
struct Args { const float* in[21]; float* out; unsigned char* ws; int ph_lo, ph_hi; };
__global__ void __launch_bounds__(NWAVES * 64, 2) hymba_fwd(Args args) {
    extern __shared__ __attribute__((aligned(16))) unsigned char lds[];
    Frame F;
    F.lds = (LAS unsigned char*)lds; F.ldsg = lds;
    F.MISC = (volatile LAS unsigned*)(F.lds + MISC_OFF);
    F.tid = threadIdx.x; F.lane = F.tid & 63; F.wave = __builtin_amdgcn_readfirstlane(F.tid >> 6);
    F.G = gridDim.x; { const int bx = blockIdx.x; F.vcu = (F.G % 8 == 0) ? (bx % 8) * (F.G / 8) + bx / 8 : bx; }
    F.ws = args.ws; F.ctl = (gu32*)(args.ws + WS_CTL); F.out = args.out;
    F.x = args.in[0]; F.p = args.in[1]; F.g_mix = args.in[2]; F.w_in = args.in[3]; F.beta_attn = args.in[4]; F.w_pool = args.in[5]; F.pool_scale = args.in[6]; F.w_out = args.in[7];
    F.g_ffn = args.in[8]; F.w_rg = args.in[9]; F.b_rg = args.in[10]; F.w_re = args.in[11]; F.b_re = args.in[12]; F.w_eg = args.in[13]; F.w_eu = args.in[14]; F.w_ed = args.in[15];
    F.g_ple = args.in[16]; F.w_ple = args.in[17]; F.w_pg = args.in[18]; F.b_pg = args.in[19]; F.g_final = args.in[20];
    for (int u = F.tid; u < 64; u += NWAVES * 64) ((LAS unsigned*)(F.lds + LDSCTL_OFF))[u] = 0u;
    __syncthreads();
    XcdBarrier bar; bar.bar = (unsigned*)(F.ctl + CW_BAR); bar.x = 0; bar.st = nullptr;
    if (N_LAUNCHES == 1) bar = xcd_barrier_post((unsigned*)(F.ctl + CW_BAR), F.MISC + 8);
#define GRID_BAR() do { if (N_LAUNCHES == 1) xcd_barrier(bar); } while (0)
#define STAGGER(n) do { if (N_LAUNCHES == 1 && (n) > 0) { const int g_ = (cid >> 3) & 3; for (int k_ = 0; k_ < g_ * (n); ++k_) __builtin_amdgcn_s_sleep(127); } } while (0)
    const int lo = args.ph_lo, hi = args.ph_hi;
#define IN(k) (lo <= (k) && (k) < hi)
#define BOTH(k) (IN(k) && IN((k) + 1))
    const int cid = (int)blockIdx.x;

    if (IN(0)) { p0_prologue(F); if (PROBE_DUP == 0) { GRID_BAR(); p0_prologue(F); } if (BOTH(0)) GRID_BAR(); }

    if (IN(1)) {
#define PHASE_GEMM_1 \
        EpiBf16 E{WSP(bf16, WS_PROJ), NIN, 0, WSP(float, WS_RS0)}; \
        { DenseSched S; S.ord.init(T / 256, NIN / 256, F.G, cid); S.A = (const char*)WSP(bf16, WS_XN); S.Bt = (const char*)WSP(bf16, WS_WIN); S.a_tile = (size_t)256 * DM * 2; S.b_tile = (size_t)256 * DM * 2; S.a_pn_off = 0; \
          if (split_) S.ord.lim = K1_ * F.G;                         \
          pg8::gemm_phase<EpiBf16, DenseSched, false>(F.lds + RING_OFF, DM * 2, DM, S, E); } \
        if (split_) { DenseSched S; S.ord.init(T / 256, NIN / 256, F.G - NC_, cid - NC_); S.A = (const char*)WSP(bf16, WS_XN); S.Bt = (const char*)WSP(bf16, WS_WIN); S.a_tile = (size_t)256 * DM * 2; S.b_tile = (size_t)256 * DM * 2; S.a_pn_off = 0; \
          S.ord.L0 = K1_ * F.G;                                      \
          pg8::gemm_phase<EpiBf16, DenseSched, false>(F.lds + RING_OFF, DM * 2, DM, S, E); } \

#define PHASE_BODY_1 \
        constexpr int NC_ = P1_NC, K1_ = P1_K1; \
        const bool split_ = (F.G == 256); const int npart_ = split_ ? NC_ : F.G; \
        if (cid < npart_) conv_experts(F, cid, npart_); \
        __syncthreads(); \
        PHASE_GEMM_1 \

        { PHASE_BODY_1 }
        if (PROBE_DUP == 1) { GRID_BAR(); { PHASE_BODY_1 } }
        if (PROBE_DUP == 101) { GRID_BAR(); { constexpr int NC_ = 128, K1_ = 6; const bool split_ = (F.G == 256); PHASE_GEMM_1 } }
        if (PROBE_DUP == 102) { GRID_BAR(); { constexpr int NC_ = 128; const bool split_ = (F.G == 256); const int npart_ = split_ ? NC_ : F.G; if (cid < npart_) conv_experts(F, cid, npart_); __syncthreads(); } }
        if (BOTH(1)) GRID_BAR();
    }
    if (IN(2)) { p2_kmean_z(F); if (PROBE_DUP == 2) { GRID_BAR(); p2_kmean_z(F); } if (BOTH(2)) GRID_BAR(); }
    if (IN(3)) {
#define PHASE_BODY_3 \
        DenseSched S; S.ord.init(T / 256, NPG, F.G, cid); S.A = (const char*)WSP(bf16, WS_Z); S.Bt = (const char*)WSP(bf16, WS_WPOOL); S.a_tile = (size_t)256 * PW * 2; S.b_tile = (size_t)PG * PG * 2; S.a_pn_off = PG * 2; \
        EpiBf16 E{WSP(bf16, WS_MIX), DM, AW, WSP(float, WS_RS0) + 65536}; \
        pg8::gemm_phase<EpiBf16, DenseSched, false>(F.lds + RING_OFF, PW * 2, PG, S, E); \
        __syncthreads(); \
        attn_gate_lists(F); \

        { PHASE_BODY_3 }
        if (PROBE_DUP == 103) { GRID_BAR(); attn_gate_lists(F, true); }
        if (PROBE_DUP == 104) { GRID_BAR(); { DenseSched S; S.ord.init(T / 256, NPG, F.G, cid); S.A = (const char*)WSP(bf16, WS_Z); S.Bt = (const char*)WSP(bf16, WS_WPOOL); S.a_tile = (size_t)256 * PW * 2; S.b_tile = (size_t)PG * PG * 2; S.a_pn_off = PG * 2; EpiBf16 E{WSP(bf16, WS_MIX), DM, AW, WSP(float, WS_RS0) + 65536}; pg8::gemm_phase<EpiBf16, DenseSched, false>(F.lds + RING_OFF, PW * 2, PG, S, E); } }
        if (BOTH(3)) GRID_BAR();
    }
    if (IN(4)) { attn_all(F); if (PROBE_DUP == 4) { GRID_BAR(); attn_all(F); } if (BOTH(4)) GRID_BAR(); }
    if (IN(6)) { p4_mix_norm(F); if (PROBE_DUP == 6) { GRID_BAR(); p4_mix_norm(F); } if (BOTH(6)) GRID_BAR(); }
    if (IN(7)) {
#define PHASE_BODY_7 \
        DenseSched S; S.ord.init(T / 256, DM / 256, F.G, cid); S.A = (const char*)WSP(bf16, WS_MIX); S.Bt = (const char*)WSP(bf16, WS_WOUT); S.a_tile = (size_t)256 * DM * 2; S.b_tile = (size_t)256 * DM * 2; S.a_pn_off = 0; \
        EpiResBf16 E{WSP(bf16, WS_XN), (bf16*)F.out, DM, WSP(float, WS_SSQ)}; \
        pg8::gemm_phase<EpiResBf16, DenseSched, false>(F.lds + RING_OFF, DM * 2, DM, S, E); \

        STAGGER(STAG7);
        { PHASE_BODY_7 }
        if (PROBE_DUP == 7) { GRID_BAR(); { PHASE_BODY_7 } }
        if (BOTH(7)) GRID_BAR();
    }
    if (IN(9)) {
#define PHASE_BODY_9 \
        DenseSched S; S.ord.init(T / 256, 2, F.G, cid); S.A = (const char*)F.out  ; S.Bt = (const char*)WSP(bf16, WS_WR); S.a_tile = (size_t)256 * DM * 2; S.b_tile = (size_t)(DM / 2) * 2; S.a_pn_off = (size_t)(DM / 2) * 2; \
        EpiLogit E{WSP(float, WS_LOGIT)}; \
        pg8::gemm_phase<EpiLogit, DenseSched, false, GEMM_ALIGN, GEMM_SP2, true>(F.lds + RING_OFF, DM * 2, DM / 2, S, E, DM);        \

        { PHASE_BODY_9 }
        if (PROBE_DUP == 9) { GRID_BAR(); { PHASE_BODY_9 } }
        if (BOTH(9)) GRID_BAR();
    }
    if (IN(10)) { p8_route(F); if (BOTH(10)) GRID_BAR(); }
    if (IN(12)) {
#define PHASE_BODY_12 \
        const int TT = build_tile_table(F); \
        MoeSched S; S.TT = TT; S.NCT = 4; S.G = F.G; S.c = cid; S.tile_e = (const LAS int*)(F.lds + TAB_OFF); S.A = (const char*)F.out  ; S.Bt = (const char*)WSP(bf16, WS_WGU); \
        S.b_exp = (size_t)1024 * DM * 2; S.b_ct = (size_t)256 * DM * 2; S.a_tile = 0; S.elist = (const int*)(F.ws + WS_ROUTE + RT_ELIST); S.a_row = DM * 2; \
        EpiGU E{WSP(bf16, WS_MIX), WSP(float, WS_ERS)}; \
        pg8::gemm_phase<EpiGU, MoeSched, true>(F.lds + RING_OFF, 0u, DM, S, E); \

        { PHASE_BODY_12 }
        if (PROBE_DUP == 12) { GRID_BAR(); { PHASE_BODY_12 } }
        if (BOTH(12)) GRID_BAR();
    }
    if (IN(13)) {
#define PHASE_BODY_13 \
        const int TT = (N_LAUNCHES == 1) ? ((const LAS int*)(F.lds + TAB_OFF))[MAXTILES + 64] : build_tile_table(F);        \
        MoeSched S; S.TT = TT; S.NCT = 8; S.G = F.G; S.c = cid; S.tile_e = (const LAS int*)(F.lds + TAB_OFF); S.A = (const char*)WSP(bf16, WS_MIX); S.Bt = (const char*)WSP(bf16, WS_WD); \
        S.b_exp = (size_t)DM * DE * 2; S.b_ct = (size_t)256 * DE * 2; S.a_tile = (size_t)256 * DE * 2; S.elist = (const int*)(F.ws + WS_ROUTE + RT_ELIST); S.a_row = 0; \
        EpiDown E{WSP(bf16, WS_PROJ), (const int*)(F.ws + WS_ROUTE + RT_ELIST), (const float*)(F.ws + WS_ROUTE + RT_EWL), WSP(bf16, WS_Z)};        \
        pg8::gemm_phase<EpiDown, MoeSched, false>(F.lds + RING_OFF, DE * 2, DE, S, E); \

        { PHASE_BODY_13 }
        if (PROBE_DUP == 13) { GRID_BAR(); { PHASE_BODY_13 } }
        if (BOTH(13)) GRID_BAR();
    }
    if (IN(14)) { p12_combine(F); __syncthreads(); }
    if (IN(15)) {
#define PHASE_BODY_15 \
        DenseSched S; S.ord.init(T / 256, DM / 256, F.G, cid); S.A = (const char*)WSP(bf16, WS_PBF); S.Bt = (const char*)WSP(bf16, WS_WPLE); S.a_tile = (size_t)256 * PLE * 2; S.b_tile = (size_t)256 * PLE * 2; S.a_pn_off = 0; \
        EpiBf16 E{WSP(bf16, WS_MIX), DM, 0, WSP(float, WS_RS0) + 65536}; \
        pg8::gemm_phase<EpiBf16, DenseSched, false>(F.lds + RING_OFF, PLE * 2, PLE, S, E); \

        { PHASE_BODY_15 }
        if (PROBE_DUP == 15) { GRID_BAR(); { PHASE_BODY_15 } }
        if (BOTH(15)) GRID_BAR();
    }
    if (IN(16)) {
        STAGGER(STAG16);
#define PHASE_BODY_16 \
        DenseSched S; S.ord.init(T / 256, DM / 256, F.G, cid); S.A = (const char*)F.out  ; S.Bt = (const char*)WSP(bf16, WS_WPG); S.a_tile = (size_t)256 * DM * 2; S.b_tile = (size_t)256 * DM * 2; S.a_pn_off = 0; \
        EpiPle E{(const bf16*)F.out, WSP(bf16, WS_PROJ), WSP(bf16, WS_MIX), F.b_pg, WSP(float, WS_RS3)}; \
        pg8::gemm_phase<EpiPle, DenseSched, false>(F.lds + RING_OFF, DM * 2, DM, S, E); \

        { PHASE_BODY_16 }
        if (PROBE_DUP == 16) { GRID_BAR(); { PHASE_BODY_16 } }
        if (BOTH(16)) GRID_BAR();
    }
    if (IN(17)) { p15_final(F); if (PROBE_DUP == 17) { GRID_BAR(); p15_final(F); } }
#undef IN
#undef BOTH
}

extern "C" void kernel_launch(void* const* d_in, const int* in_sizes, int n_in, void* d_out, int out_size, void* d_ws, size_t ws_size, hipStream_t stream) {
    static int grid = 0;
    if (grid == 0) {
        if (n_in != 21 || in_sizes[0] != T * DM || out_size != T * DM || ws_size < WS_END2) { fprintf(stderr, "kernel_launch: shape mismatch n_in %d in0 %d out %d ws %zu (need %zu)\n", n_in, n_in > 0 ? in_sizes[0] : -1, out_size, ws_size, (size_t)WS_END2); grid = -1; return; }
        int dev = 0, cus = 0, per_cu = 0;
        if (hipGetDevice(&dev) != hipSuccess || hipDeviceGetAttribute(&cus, hipDeviceAttributeMultiprocessorCount, dev) != hipSuccess) { grid = -1; return; }
        if (hipFuncSetAttribute((const void*)hymba_fwd, hipFuncAttributeMaxDynamicSharedMemorySize, LDS_BYTES) != hipSuccess) { fprintf(stderr, "kernel_launch: hipFuncSetAttribute failed\n"); grid = -1; return; }
        if (hipOccupancyMaxActiveBlocksPerMultiprocessor(&per_cu, (const void*)hymba_fwd, NWAVES * 64, LDS_BYTES) != hipSuccess || per_cu < 1) { fprintf(stderr, "kernel_launch: occupancy query says %d\n", per_cu); }
        (void)hipGetLastError();
        grid = cus;
    }
    if (grid < 0) return;
    (void)hipMemsetAsync((char*)d_ws + WS_CTL, 0, CTL_ZERO_BYTES, stream);
    Args a{};
    for (int i = 0; i < 21; ++i) a.in[i] = (const float*)d_in[i];
    a.out = (float*)d_out; a.ws = (unsigned char*)d_ws;
    if (N_LAUNCHES == 1) { a.ph_lo = 0; a.ph_hi = NPHASES; hipLaunchKernelGGL(hymba_fwd, dim3(grid), dim3(NWAVES * 64), LDS_BYTES, stream, a); }
    else { for (int li = 0; li < NPHASES; ++li) { a.ph_lo = li; a.ph_hi = li + 1; hipLaunchKernelGGL(hymba_fwd, dim3(grid), dim3(NWAVES * 64), LDS_BYTES, stream, a); } }
    const hipError_t le = hipPeekAtLastError();
    if (le != hipSuccess) fprintf(stderr, "kernel_launch: launch failed: %s\n", hipGetErrorName(le));
}
```

```cpp
#include <hip/hip_runtime.h>
#include <cstdio>
#include <cstdint>

namespace pg8 {
#define PG8_LAS __attribute__((address_space(3)))
typedef unsigned short bf16_t;
typedef short bf16x8 __attribute__((ext_vector_type(8)));
typedef float f32x4 __attribute__((ext_vector_type(4)));
typedef unsigned u32x4 __attribute__((ext_vector_type(4)));
typedef unsigned u32x2 __attribute__((ext_vector_type(2)));
constexpr int BM = 256, BK = 64, HALF = 128, HTB = HALF * BK * 2  , STAGE_BYTES = 8 * HTB, NXCD = 8, WGM = 8;

__host__ __device__ __forceinline__ int lds_byte(int r, int c) { const int st = (r >> 4) * 2 + (c >> 5), rr = r & 15, cc = c & 31, ob = rr * 64 + cc * 2; return st * 1024 + (ob ^ (((ob >> 9) & 1) << 5)); }
__host__ __device__ __forceinline__ void stage_rc(int b, int& R, int& C) { const int st = b / 1024, sb = b % 1024, swz = sb ^ (((sb >> 9) & 1) << 5); R = (st >> 1) * 16 + swz / 64; C = (st & 1) * 32 + (swz % 64) / 2; }
__host__ __device__ __forceinline__ int perm32(int rho) { const int n = rho >> 4, i = rho & 15; return 8 * (i >> 2) + 4 * n + (i & 3); }

struct Unit { const char* a; const char* b; int pm, pn, x0, x1; };

struct TileOrder {
    int nM, nN, nwg, G, c, L0, lim;
    __device__ __forceinline__ void init(int nM_, int nN_, int G_, int c_) { nM = nM_; nN = nN_; nwg = nM * nN; G = G_; c = c_; L0 = 0; lim = nwg; }
    __device__ __forceinline__ bool tile(int i, int& pm, int& pn) const { return map((long)L0 + (long)i * G + c, pm, pn); }
    __device__ __forceinline__ bool map(long L, int& pm, int& pn) const {
        if (c < 0 || L >= lim) return false;
        int wgid = (int)L; { const int q = nwg / NXCD, r = nwg % NXCD, xcd = wgid % NXCD, off = wgid / NXCD; wgid = (xcd < r ? xcd * (q + 1) : r * (q + 1) + (xcd - r) * q) + off; }
        const int nig = WGM * nN, gid = wgid / nig, fm = gid * WGM, gsz = (nM - fm) < WGM ? (nM - fm) : WGM;
        pm = fm + ((wgid % nig) % gsz); pn = (wgid % nig) / gsz; return true;
    }
};

__device__ __forceinline__ unsigned cvt_pk_bf16(float lo, float hi) { unsigned r; asm volatile("v_cvt_pk_bf16_f32 %0, %1, %2" : "=v"(r) : "v"(lo), "v"(hi)); return r; }

#ifndef GEMM_ALIGN
#define GEMM_ALIGN true
#endif
#ifndef GEMM_SP2
#define GEMM_SP2 true
#endif
#ifndef EPI_RELAX
#define EPI_RELAX 1
#endif
template <class Epi, class Sched, bool GATHER, bool ALIGN_EPI = GEMM_ALIGN, bool SP2 = GEMM_SP2, bool HALFN = false>
__device__ __forceinline__ void gemm_phase(PG8_LAS unsigned char* lds, const unsigned lda, const int K, const Sched& S, const Epi& E, const int ldb_ = 0) {
    const int tid = threadIdx.x, wid = __builtin_amdgcn_readfirstlane(tid >> 6), lane = tid & 63, wr = wid >> 2, wc = wid & 3, fr = lane & 15, fq = lane >> 4;
    const int nt = K / BK, ldb = ldb_ ? ldb_ : K;
    unsigned voffB[2]; int RA[2], CA[2];
#pragma unroll
    for (int i = 0; i < 2; ++i) { int R, C; stage_rc(tid * 16 + i * 8192, R, C); const int Rb = Epi::PERM ? ((R & ~31) + perm32(R & 31)) : R;
        RA[i] = R; CA[i] = C; voffB[i] = (unsigned)(Rb * ldb + C) * 2u; }
    const size_t kstep = (size_t)(BK * 2);
    const size_t hstepB = (size_t)HALF * ldb * 2;
    const unsigned ldsw = (unsigned)wid * 1024u;
    const int aoff = lds_byte(wr * 64 + fr, fq * 8), boff = lds_byte(wc * 32 + fr, fq * 8);
#define PG8_SA(b, h) (((b) * 2 + (h)) * HTB)
#define PG8_SB(b, h) ((4 + (b) * 2 + (h)) * HTB)
#define PG8_STAGE(bufoff, gbase, voff) do { _Pragma("unroll") for (int _i = 0; _i < 2; ++_i) \
        __builtin_amdgcn_global_load_lds((const unsigned*)((const char*)(gbase) + (voff)[_i]), (PG8_LAS unsigned*)(lds + (bufoff) + ldsw + _i * 8192), 16, 0, 0); } while (0)
#define PG8_STAGE2(bufoff, gbase, v0, v1) do { \
        __builtin_amdgcn_global_load_lds((const unsigned*)((const char*)(gbase) + (v0)), (PG8_LAS unsigned*)(lds + (bufoff) + ldsw), 16, 0, 0); \
        __builtin_amdgcn_global_load_lds((const unsigned*)((const char*)(gbase) + (v1)), (PG8_LAS unsigned*)(lds + (bufoff) + ldsw + 8192), 16, 0, 0); } while (0)
#define PG8_LDA(dst, b, h) do { _Pragma("unroll") for (int m = 0; m < 4; ++m) _Pragma("unroll") for (int k = 0; k < 2; ++k) dst[m][k] = *(const PG8_LAS bf16x8*)(lds + PG8_SA(b, h) + aoff + m * 2048 + k * 1024); } while (0)
#define PG8_LDB(dst, b, h) do { _Pragma("unroll") for (int n = 0; n < 2; ++n) _Pragma("unroll") for (int k = 0; k < 2; ++k) dst[n][k] = *(const PG8_LAS bf16x8*)(lds + PG8_SB(b, h) + boff + n * 2048 + k * 1024); } while (0)
#define PG8_MMA(ai, bj, At, Bt) do { __builtin_amdgcn_s_setprio(1); _Pragma("unroll") for (int m = 0; m < 4; ++m) _Pragma("unroll") for (int n = 0; n < 2; ++n) _Pragma("unroll") for (int k = 0; k < 2; ++k) \
        acc[ai][bj][m][n] = __builtin_amdgcn_mfma_f32_16x16x32_bf16(Bt[n][k], At[m][k], acc[ai][bj][m][n], 0, 0, 0); __builtin_amdgcn_s_setprio(0); } while (0)
#define PG8_WAIT_V(n) asm volatile("s_waitcnt vmcnt(" #n ")" ::: "memory")
#define PG8_WAIT_L(n) asm volatile("s_waitcnt lgkmcnt(" #n ")" ::: "memory")
#define PG8_WAIT_V8_OR_24(r) asm volatile("s_cmp_lg_u32 %0, 0\n\ts_cbranch_scc1 1f\n\ts_waitcnt vmcnt(8)\n1:\n\ts_waitcnt vmcnt(24)" :: "s"(r) : "memory", "scc")
#define PG8_BAR __builtin_amdgcn_s_barrier()
#define PG8_SCHED __builtin_amdgcn_sched_barrier(0)
    Unit cur, nxt; int ui = 0;
    if (!S.next(0, cur)) return;
    unsigned c00, c01, c10, c11, n00 = 0, n01 = 0, n10 = 0, n11 = 0;
    if constexpr (GATHER) {
        c00 = S.row_off(cur, RA[0]) + CA[0] * 2u; c01 = S.row_off(cur, RA[1]) + CA[1] * 2u; c10 = S.row_off(cur, HALF + RA[0]) + CA[0] * 2u; c11 = S.row_off(cur, HALF + RA[1]) + CA[1] * 2u;
    } else {
        c00 = (unsigned)RA[0] * lda + CA[0] * 2u; c01 = (unsigned)RA[1] * lda + CA[1] * 2u; c10 = c00 + HALF * lda; c11 = c01 + HALF * lda;
    }
    f32x4 acc[2][2][4][2];
#pragma unroll
    for (int a = 0; a < 2; ++a)
#pragma unroll
        for (int b = 0; b < 2; ++b)
#pragma unroll
            for (int m = 0; m < 4; ++m)
#pragma unroll
                for (int n = 0; n < 2; ++n) acc[a][b][m][n] = (f32x4){0.f, 0.f, 0.f, 0.f};
    bf16x8 At[4][2], B0[2][2], B1[2][2];
    const char* cA = cur.a; const char* cB = cur.b;
    if constexpr (SP2) {
        PG8_STAGE(PG8_SB(0, 0), cB, voffB); PG8_STAGE(PG8_SB(0, 1), cB + hstepB, voffB); PG8_STAGE2(PG8_SA(0, 0), cA, c00, c01); PG8_STAGE2(PG8_SA(0, 1), cA, c10, c11);
        if (wr == 1) PG8_BAR;
        PG8_WAIT_V(2); PG8_BAR;
        PG8_STAGE(PG8_SB(1, 0), cB + kstep, voffB); PG8_STAGE2(PG8_SA(1, 0), cA + kstep, c00, c01); PG8_STAGE(PG8_SB(1, 1), cB + hstepB + kstep, voffB);
        PG8_WAIT_V(6); PG8_BAR;
    } else {
        PG8_STAGE(PG8_SB(0, 0), cB, voffB); PG8_STAGE2(PG8_SA(0, 0), cA, c00, c01); PG8_STAGE(PG8_SB(0, 1), cB + hstepB, voffB); PG8_STAGE2(PG8_SA(0, 1), cA, c10, c11);
        if (wr == 1) PG8_BAR;
        PG8_WAIT_V(4); PG8_BAR;
        PG8_STAGE(PG8_SB(1, 0), cB + kstep, voffB); PG8_STAGE2(PG8_SA(1, 0), cA + kstep, c00, c01); PG8_STAGE(PG8_SB(1, 1), cB + hstepB + kstep, voffB);
        PG8_WAIT_V(6); PG8_BAR;
    }
    for (;;) {
        const bool has_next = S.next(ui + 1, nxt);
        const char* nA = has_next ? nxt.a : cA; const char* nB = has_next ? nxt.b : cB;
        if constexpr (GATHER) {
            if (has_next) { n00 = S.row_off(nxt, RA[0]) + CA[0] * 2u; n01 = S.row_off(nxt, RA[1]) + CA[1] * 2u; n10 = S.row_off(nxt, HALF + RA[0]) + CA[0] * 2u; n11 = S.row_off(nxt, HALF + RA[1]) + CA[1] * 2u; }
            else { n00 = c00; n01 = c01; n10 = c10; n11 = c11; }
        }
        for (int t = 0; t < nt; t += 2) {
            const bool last = (t == nt - 2);
            const char* a1 = cA + (size_t)(t + 1) * kstep;
            const char* a2 = last ? nA : cA + (size_t)(t + 2) * kstep; const char* b2 = last ? nB : cB + (size_t)(t + 2) * kstep;
            const char* a3 = a2 + kstep; const char* b3 = b2 + kstep;
            unsigned v00 = c00, v01 = c01, v10 = c10, v11 = c11;
            if constexpr (GATHER) { if (last) { v00 = n00; v01 = n01; v10 = n10; v11 = n11; } }
            if constexpr (SP2) {
            const int rel = __builtin_amdgcn_readfirstlane(((Epi::NST == 16) && EPI_RELAX && (t == 0) && (ui > 0)) ? 1 : 0);
            PG8_LDB(B0, 0, 0); if constexpr (!HALFN) PG8_LDB(B1, 0, 1); PG8_SCHED; PG8_LDA(At, 0, 0); PG8_STAGE2(PG8_SA(1, 1), a1, c10, c11);
            PG8_WAIT_V8_OR_24(rel);
            PG8_WAIT_L(0); PG8_BAR; PG8_MMA(0, 0, At, B0); if constexpr (!HALFN) PG8_MMA(0, 1, At, B1); PG8_BAR; PG8_SCHED;
            PG8_LDA(At, 0, 1); PG8_STAGE(PG8_SB(0, 0), b2, voffB); PG8_STAGE(PG8_SB(0, 1), b2 + hstepB, voffB); PG8_STAGE2(PG8_SA(0, 0), a2, v00, v01);
            PG8_WAIT_V8_OR_24(rel);
            PG8_WAIT_L(0); PG8_BAR; PG8_MMA(1, 0, At, B0); if constexpr (!HALFN) PG8_MMA(1, 1, At, B1); PG8_BAR; PG8_SCHED;
            PG8_LDB(B0, 1, 0); if constexpr (!HALFN) PG8_LDB(B1, 1, 1); PG8_SCHED; PG8_LDA(At, 1, 0); PG8_STAGE2(PG8_SA(0, 1), a2, v10, v11);
            PG8_WAIT_V(8); PG8_WAIT_L(0); PG8_BAR; PG8_MMA(0, 0, At, B0); if constexpr (!HALFN) PG8_MMA(0, 1, At, B1); PG8_BAR; PG8_SCHED;
            PG8_LDA(At, 1, 1); PG8_STAGE(PG8_SB(1, 0), b3, voffB); PG8_STAGE(PG8_SB(1, 1), b3 + hstepB, voffB); PG8_STAGE2(PG8_SA(1, 0), a3, v00, v01);
            PG8_WAIT_V(8); PG8_WAIT_L(0); PG8_BAR; PG8_MMA(1, 0, At, B0); if constexpr (!HALFN) PG8_MMA(1, 1, At, B1); PG8_BAR; PG8_SCHED;
            } else {
            PG8_LDB(B0, 0, 0); PG8_SCHED; PG8_LDA(At, 0, 0); PG8_STAGE2(PG8_SA(1, 1), a1, c10, c11);
            PG8_WAIT_L(8); PG8_BAR; PG8_WAIT_L(0); PG8_MMA(0, 0, At, B0); PG8_BAR; PG8_SCHED;
            PG8_LDB(B1, 0, 1); PG8_STAGE(PG8_SB(0, 0), b2, voffB);
            PG8_BAR; PG8_WAIT_L(0); PG8_MMA(0, 1, At, B1); PG8_BAR;
            PG8_LDA(At, 0, 1); PG8_STAGE2(PG8_SA(0, 0), a2, v00, v01);
            PG8_BAR; PG8_WAIT_L(0); PG8_MMA(1, 0, At, B0); PG8_BAR; PG8_SCHED;
            PG8_STAGE(PG8_SB(0, 1), b2 + hstepB, voffB);
            PG8_WAIT_V(6); PG8_BAR; PG8_MMA(1, 1, At, B1); PG8_BAR;
            PG8_LDB(B0, 1, 0); PG8_SCHED; PG8_LDA(At, 1, 0); PG8_STAGE2(PG8_SA(0, 1), a2, v10, v11);
            PG8_WAIT_L(8); PG8_BAR; PG8_WAIT_L(0); PG8_MMA(0, 0, At, B0); PG8_BAR; PG8_SCHED;
            PG8_LDB(B1, 1, 1); PG8_STAGE(PG8_SB(1, 0), b3, voffB);
            PG8_BAR; PG8_WAIT_L(0); PG8_MMA(0, 1, At, B1); PG8_BAR;
            PG8_LDA(At, 1, 1); PG8_STAGE2(PG8_SA(1, 0), a3, v00, v01);
            PG8_BAR; PG8_WAIT_L(0); PG8_MMA(1, 0, At, B0); PG8_BAR; PG8_SCHED;
            PG8_STAGE(PG8_SB(1, 1), b3 + hstepB, voffB);
            PG8_WAIT_V(6); PG8_BAR; PG8_MMA(1, 1, At, B1); PG8_BAR;
            }
        }
        if constexpr (ALIGN_EPI) { if (wr == 0) PG8_BAR; }
        E(acc, cur, wr, wc, fr, fq);
        if (!has_next) break;
#pragma unroll
        for (int a = 0; a < 2; ++a)
#pragma unroll
            for (int b = 0; b < 2; ++b)
#pragma unroll
                for (int m = 0; m < 4; ++m)
#pragma unroll
                    for (int n = 0; n < 2; ++n) acc[a][b][m][n] = (f32x4){0.f, 0.f, 0.f, 0.f};
        cur = nxt; cA = nA; cB = nB; ++ui;
        if constexpr (GATHER) { c00 = n00; c01 = n01; c10 = n10; c11 = n11; }
        if constexpr (ALIGN_EPI) { if (wr == 1) PG8_BAR; }
    }
    PG8_WAIT_V(0);
    if constexpr (!ALIGN_EPI) { if (wr == 0) PG8_BAR; }
    PG8_BAR;
#undef PG8_SA
#undef PG8_SB
#undef PG8_STAGE
#undef PG8_STAGE2
#undef PG8_LDA
#undef PG8_LDB
#undef PG8_MMA
#undef PG8_WAIT_V
#undef PG8_WAIT_L
#undef PG8_BAR
#undef PG8_SCHED
}
}

constexpr int NWAVES = 8;
constexpr int BATCH = 4, SEQ = 8192, DM = 2048, T = BATCH * SEQ;
constexpr int AW = 1024, NH = 8, HD = 128, MBLK = 256, NBLK = SEQ / MBLK, TOPK = 3;
constexpr int PW = 1024, NPG = 4, PG = 256;
constexpr int NIN = 3 * AW + PW;
constexpr int NGRP = 8, EPG = 8, NE = 64, DE = 512;
constexpr int PLE = 256;
constexpr float EPS = 1e-6f;
constexpr int NSLOT = 2 * T;
constexpr int PMAX = NSLOT + NE * 256;
constexpr int MAXTILES = PMAX / 256;

constexpr size_t MiB = 1u << 20;
constexpr size_t WS_CTL = 0, CTL_ZERO_BYTES = 1 * MiB;
constexpr size_t WS_WIN = 2 * MiB;
constexpr size_t WS_WPOOL = 18 * MiB;
constexpr size_t WS_WOUT = 19 * MiB;
constexpr size_t WS_WR = 27 * MiB;
constexpr size_t WS_WPG = 28 * MiB;
constexpr size_t WS_WPLE = 36 * MiB;
constexpr size_t WS_WGU = 40 * MiB;
constexpr size_t WS_WD = 296 * MiB;
constexpr size_t WS_XN = 424 * MiB;
constexpr size_t WS_PROJ = 552 * MiB;
constexpr size_t WS_MIX = 808 * MiB;
constexpr size_t WS_Z = 936 * MiB;
constexpr size_t WS_PBF = 1000 * MiB;
constexpr size_t WS_KMEAN = 1016 * MiB;
constexpr size_t WS_RS3 = 1020 * MiB;
constexpr size_t WS_SSQ = 936 * MiB + 8 * MiB;
constexpr size_t WS_RSF = 1021 * MiB;
constexpr size_t WS_ERS = 1024 * MiB;
constexpr size_t WS_RS0 = 1022 * MiB;
constexpr size_t WS_LOGIT = 1060 * MiB;
constexpr size_t WS_ROUTE = 1033 * MiB;
constexpr size_t WS_END = 1057 * MiB;
constexpr size_t RT_ELIST = 0, RT_EWL = 8 * MiB;
constexpr int CW_TMO = 0, CW_CODE = 1;
constexpr int CW_BAR = 4096;
constexpr int CW_ECNT = 16384;
constexpr int CW_EFILL = 16384 + 256;

constexpr int RING_OFF = 0, RING_BYTES = 131072;
constexpr int SCR_BYTES = 133120;
constexpr int LDSCTL_OFF = 135168, MISC_OFF = LDSCTL_OFF;
constexpr int TAB_OFF = LDSCTL_OFF + 256;
constexpr int LDS_BYTES = 163840;

#define GAS __attribute__((address_space(1)))
#define LAS __attribute__((address_space(3)))
typedef unsigned short bf16;
typedef unsigned v4u __attribute__((ext_vector_type(4)));
typedef unsigned v2u __attribute__((ext_vector_type(2)));
typedef float f32x4 __attribute__((ext_vector_type(4)));
typedef GAS unsigned gu32;
#define RLX_AGENT __ATOMIC_RELAXED, __HIP_MEMORY_SCOPE_AGENT
#define LDS_WAIT() asm volatile("s_waitcnt lgkmcnt(0)" ::: "memory")
#define VM_WAIT() asm volatile("s_waitcnt vmcnt(0)" ::: "memory")
typedef float f32x2_t __attribute__((ext_vector_type(2)));
typedef __bf16 bf16x2_t __attribute__((ext_vector_type(2)));
__device__ __forceinline__ unsigned pk2(float lo, float hi) { const f32x2_t v = {lo, hi}; return __builtin_bit_cast(unsigned, __builtin_convertvector(v, bf16x2_t)); }
__device__ __forceinline__ unsigned f2bf(float f) { return pk2(f, 0.f) & 0xffffu; }
__device__ __forceinline__ float bflo(unsigned w) { return __builtin_bit_cast(float, w << 16); }
__device__ __forceinline__ float bfhi(unsigned w) { return __builtin_bit_cast(float, w & 0xffff0000u); }
__device__ __forceinline__ float wave_sum(float v) {
#pragma unroll
    for (int o = 1; o < 64; o <<= 1) v += __shfl_xor(v, o);
    return v;
}
__device__ __forceinline__ float wave_max(float v) {
#pragma unroll
    for (int o = 1; o < 64; o <<= 1) v = fmaxf(v, __shfl_xor(v, o));
    return v;
}
#define XB_TMO      128
#define XB_XCNT(j)  (256  + 64 * (j))
#define XB_XSUB(j)  (1280 + 64 * (j))
#define XB_XGEN(j)  (2304 + 64 * (j))
#define XB_TOP      3328
#define XB_TOPGEN   3392
#define XCD_BAR_WORDS 3456
#define XB_SPIN_CAP (1u << 23)

__device__ __forceinline__ unsigned xb_ld(unsigned* p)              { return __hip_atomic_load(p, __ATOMIC_RELAXED, __HIP_MEMORY_SCOPE_AGENT); }
__device__ __forceinline__ unsigned xb_add(unsigned* p, unsigned v) { return __hip_atomic_fetch_add(p, v, __ATOMIC_RELAXED, __HIP_MEMORY_SCOPE_AGENT); }
__device__ __forceinline__ unsigned xb_xcc_id() { return (unsigned)__builtin_amdgcn_s_getreg((3 << 11) | 20) & 0xFu; }
#define XB_SPIN(cond, bar) do { unsigned _sp = 0; while (cond) { __builtin_amdgcn_s_sleep(1); \
    if ((++_sp & 255u) == 0u) { if (xb_ld(&(bar)[XB_TMO])) break; if (_sp > XB_SPIN_CAP) { atomicAdd(&(bar)[XB_TMO], 1u); break; } } } } while (0)

struct XcdBarrier {
    unsigned* bar; unsigned x;
    volatile LAS unsigned* st;
};

__device__ __forceinline__ XcdBarrier xcd_barrier_post(unsigned* bar, volatile LAS unsigned* st) {
    XcdBarrier b; b.bar = bar; b.x = xb_xcc_id(); b.st = st;
    if (threadIdx.x == 0) (void)xb_add(&bar[XB_XCNT(b.x)], 1u);
    return b;
}
__device__ __forceinline__ void xcd_barrier_complete(unsigned* bar, unsigned x, unsigned& nloc, unsigned& nx) {
    const unsigned G = gridDim.x * gridDim.y * gridDim.z;
    unsigned sum, cnt, mine, sp = 0u;
    for (;;) {
        sum = 0u; cnt = 0u; mine = 0u;
#pragma unroll
        for (unsigned j = 0; j < 16; ++j) { const unsigned c = xb_ld(&bar[XB_XCNT(j)]); sum += c; cnt += (c > 0u) ? 1u : 0u; mine = (j == x) ? c : mine; }
        if (sum == G) break;
        __builtin_amdgcn_s_sleep(1);
        if ((++sp & 255u) == 0u) { if (xb_ld(&bar[XB_TMO])) break; if (sp > XB_SPIN_CAP) { atomicAdd(&bar[XB_TMO], 1u); break; } }
    }
    nloc = mine > 0u ? mine : 1u; nx = cnt > 0u ? cnt : 1u;
}

__device__ __forceinline__ void xcd_barrier(const XcdBarrier& b) {
    asm volatile("s_waitcnt vmcnt(0)" ::: "memory");
    __syncthreads();
    if (threadIdx.x == 0) {
        unsigned* bar = b.bar;
        __builtin_amdgcn_s_waitcnt(0);
        unsigned nloc = b.st[0], nx = b.st[1];
        if (nloc == 0u) { xcd_barrier_complete(bar, b.x, nloc, nx); b.st[0] = nloc; b.st[1] = nx; }
        const unsigned old = xb_add(&bar[XB_XSUB(b.x)], 1u);
        const unsigned gen = old / nloc;
        if (old + 1u == (gen + 1u) * nloc) {
            __builtin_amdgcn_fence(__ATOMIC_RELEASE, "agent");
            asm volatile("s_waitcnt vmcnt(0)" ::: "memory");
            const unsigned og = xb_add(&bar[XB_TOP], 1u);
            const unsigned tg = og / nx;
            if (og + 1u == (tg + 1u) * nx) xb_add(&bar[XB_TOPGEN], 1u);
            else XB_SPIN(xb_ld(&bar[XB_TOPGEN]) == tg, bar);
            __builtin_amdgcn_fence(__ATOMIC_ACQUIRE, "agent");
            xb_add(&bar[XB_XGEN(b.x)], 1u);
            asm volatile("s_waitcnt vmcnt(0)" ::: "memory");
        } else {
            XB_SPIN(xb_ld(&bar[XB_XGEN(b.x)]) == gen, bar);
            __builtin_amdgcn_fence(__ATOMIC_ACQUIRE, "agent");
            asm volatile("s_waitcnt vmcnt(0)" ::: "memory");
        }
    }
    __syncthreads();
}

struct Frame {
    LAS unsigned char* lds; unsigned char* ldsg;
    volatile LAS unsigned* MISC;
    gu32* ctl;
    int tid, lane, wave;
    int vcu, G;
    const float *x, *p, *g_mix, *w_in, *beta_attn, *w_pool, *pool_scale, *w_out, *g_ffn, *w_rg, *b_rg, *w_re, *b_re, *w_eg, *w_eu, *w_ed, *g_ple, *w_ple, *w_pg, *b_pg, *g_final;
    float* out; unsigned char* ws;
};
#define WSP(T_, off) ((T_*)(F.ws + (off)))

struct KmId { __device__ __forceinline__ int operator()(int k) const { return k; } };
struct KmAttn { __device__ __forceinline__ int operator()(int k) const { return k < AW ? ((k & ~127) + 32 * (k & 3) + ((k & 127) >> 2)) : k; } };
template <class RowMap, class KMap = KmId>
__device__ __forceinline__ void tr64_item(const float* W, int ldw, bf16* WT, int ldt, int k0, int n0, const RowMap& rm, LAS float* scr, int lane, const KMap& km = KMap(), const float* kg = nullptr) {
    f32x4 v[16];
#pragma unroll
    for (int i = 0; i < 16; ++i) { const int k = 4 * i + (lane >> 4), n4 = (lane & 15) * 4; v[i] = *(const GAS f32x4*)(W + (size_t)km(k0 + k) * ldw + n0 + n4); }
#pragma unroll
    for (int i = 0; i < 16; ++i) { const int k = 4 * i + (lane >> 4), n4 = (lane & 15) * 4;
        LAS float* s = scr + k * 65 + n4; const float gk = kg ? kg[k0 + k] : 1.f; s[0] = v[i].x * gk; s[1] = v[i].y * gk; s[2] = v[i].z * gk; s[3] = v[i].w * gk; }
    LDS_WAIT();
    const int c = lane & 7;
#pragma unroll
    for (int j = 0; j < 8; ++j) { const int n = (lane >> 3) + 8 * j; const LAS float* s = scr + (8 * c) * 65 + n;
        v4u o; o.x = pk2(s[0 * 65], s[1 * 65]); o.y = pk2(s[2 * 65], s[3 * 65]); o.z = pk2(s[4 * 65], s[5 * 65]); o.w = pk2(s[6 * 65], s[7 * 65]);
        *(GAS v4u*)(WT + (size_t)rm(n0 + n) * ldt + k0 + 8 * c) = o; }
    LDS_WAIT();
}
struct RmId { __device__ __forceinline__ int operator()(int n) const { return n; } };
template <class KMap = KmId>
__device__ __forceinline__ void tr64_load(const float* W, int ldw, int k0, int n0, int lane, f32x4 (&v)[16], const KMap& km = KMap()) {
#pragma unroll
    for (int i = 0; i < 16; ++i) { const int k = 4 * i + (lane >> 4), n4 = (lane & 15) * 4; v[i] = __builtin_nontemporal_load((const GAS f32x4*)(W + (size_t)km(k0 + k) * ldw + n0 + n4)); }
}
template <class RowMap>
__device__ __forceinline__ void tr64_finish(const f32x4 (&v)[16], bf16* WT, int ldt, int k0, int n0, const RowMap& rm, LAS float* scr, int lane, const LAS float* lg, int gsel) {
    const float gm_ = gsel >= 0 ? 1.f : 0.f; const LAS float* gp_ = lg + (gsel > 0 ? 2048 : 0);
#pragma unroll
    for (int i = 0; i < 16; ++i) { const int k = 4 * i + (lane >> 4), n4 = (lane & 15) * 4;
        LAS float* s = scr + k * 65 + n4; const float gk = fmaf(gp_[k0 + k], gm_, 1.f - gm_); s[0] = v[i].x * gk; s[1] = v[i].y * gk; s[2] = v[i].z * gk; s[3] = v[i].w * gk; }
    LDS_WAIT();
    const int c = lane & 7;
#pragma unroll
    for (int j = 0; j < 8; ++j) { const int n = (lane >> 3) + 8 * j; const LAS float* s = scr + (8 * c) * 65 + n;
        v4u o; o.x = pk2(s[0 * 65], s[1 * 65]); o.y = pk2(s[2 * 65], s[3 * 65]); o.z = pk2(s[4 * 65], s[5 * 65]); o.w = pk2(s[6 * 65], s[7 * 65]);
        __builtin_nontemporal_store(o, (GAS v4u*)(WT + (size_t)rm(n0 + n) * ldt + k0 + 8 * c)); }
    LDS_WAIT();
}

struct RmGU { int add; __device__ __forceinline__ int operator()(int n) const { return ((n >> 2) << 3) + (n & 3) + add; } };

__device__ __forceinline__ void row_load(const float* row, int lane, f32x4 (&v)[8]) {
    const GAS f32x4* xr = (const GAS f32x4*)row + lane;
#pragma unroll
    for (int j = 0; j < 8; ++j) v[j] = xr[64 * j];
}
__device__ __forceinline__ void row_load_nt(const float* row, int lane, f32x4 (&v)[8]) {
    const GAS f32x4* xr = (const GAS f32x4*)row + lane;
#pragma unroll
    for (int j = 0; j < 8; ++j) v[j] = __builtin_nontemporal_load(xr + 64 * j);
}
__device__ __forceinline__ float row_ss(const f32x4 (&v)[8]) {
    float s = 0.f;
#pragma unroll
    for (int j = 0; j < 8; ++j) s += (v[j].x * v[j].x + v[j].y * v[j].y) + (v[j].z * v[j].z + v[j].w * v[j].w);
    return wave_sum(s);
}
__device__ __forceinline__ void row_norm_bf16(const f32x4 (&v)[8], float ss, const float* gain, bf16* orow, int lane) {
    const float r = 1.0f / sqrtf(ss * (1.f / DM) + EPS);
    GAS unsigned long long* o8 = (GAS unsigned long long*)orow + lane;
    const GAS f32x4* g4 = (const GAS f32x4*)gain + lane;
#pragma unroll
    for (int j = 0; j < 8; ++j) { const f32x4 g = g4[64 * j];
        o8[64 * j] = (unsigned long long)pk2(v[j].x * r * g.x, v[j].y * r * g.y) | ((unsigned long long)pk2(v[j].z * r * g.z, v[j].w * r * g.w) << 32); }
}

__device__ __forceinline__ void row_norm_bf16_g(const f32x4 (&v)[8], float ss, const f32x4 (&g)[8], bf16* orow, int lane) {
    const float r = 1.0f / sqrtf(ss * (1.f / DM) + EPS);
    GAS unsigned long long* o8 = (GAS unsigned long long*)orow + lane;
#pragma unroll
    for (int j = 0; j < 8; ++j)
        o8[64 * j] = (unsigned long long)pk2(v[j].x * r * g[j].x, v[j].y * r * g[j].y) | ((unsigned long long)pk2(v[j].z * r * g[j].z, v[j].w * r * g[j].w) << 32);
}
__device__ __forceinline__ void p0_prologue(Frame& F) {
    LAS float* scr = (LAS float*)(F.lds + F.wave * 16640);
    const int gw = F.vcu * NWAVES + F.wave, NGW = F.G * NWAVES;
    constexpr int I_WIN = 32 * 64;
    for (int it = gw; it < I_WIN; it += NGW) tr64_item(F.w_in, NIN, WSP(bf16, WS_WIN), DM, 64 * (it / 64), 64 * (it % 64), RmId{}, scr, F.lane, KmId{}, F.g_mix);
    const int gt = F.vcu * (NWAVES * 64) + F.tid, NGT = F.G * NWAVES * 64;
    { bf16* wr = WSP(bf16, WS_WR);
      for (int i = gt; i < 256 * DM; i += NGT) { const int n = i / DM, k = i % DM; float v = 0.f;
          if (n < 8) v = F.w_rg[k * 8 + n]; else if (n < 72) { const int g = (n - 8) >> 3, e = (n - 8) & 7; v = F.w_re[((size_t)g * DM + k) * 8 + e]; }
          wr[i] = (bf16)f2bf(v * F.g_ffn[k]); } }
    { const GAS f32x4* ps = (const GAS f32x4*)F.p; GAS v2u* pd = (GAS v2u*)WSP(bf16, WS_PBF);
      static_assert((T * PLE / 4) % (256 * NWAVES * 64 * 8) == 0, "p copy: eight loads per trip");
      if (F.G == 256) {
        for (int i = gt; i < T * PLE / 4; i += 8 * NGT) { f32x4 v[8];
#pragma unroll
            for (int k = 0; k < 8; ++k) v[k] = __builtin_nontemporal_load(ps + i + k * NGT);
#pragma unroll
            for (int k = 0; k < 8; ++k) { v2u o; o.x = pk2(v[k].x, v[k].y); o.y = pk2(v[k].z, v[k].w); pd[i + k * NGT] = o; } }
      } else for (int i = gt; i < T * PLE / 4; i += NGT) { const f32x4 v = ps[i]; v2u o; o.x = pk2(v.x, v.y); o.y = pk2(v.z, v.w); pd[i] = o; } }
    { float* ones = WSP(float, WS_RS0) + 65536; for (int i = gt; i < T; i += NGT) ones[i] = 1.0f; }
    { f32x4 v[8]; row_load_nt(F.x + (size_t)gw * DM, F.lane, v); VM_WAIT();
      for (int m = gw; m < T; m += NGW) { const int mn = (m + NGW < T) ? m + NGW : m; f32x4 vn[8]; row_load_nt(F.x + (size_t)mn * DM, F.lane, vn);
          const float ss = row_ss(v); if (F.lane == 0) WSP(float, WS_RS0)[m] = 1.0f / sqrtf(ss * (1.f / DM) + EPS);
          { GAS unsigned long long* o8 = (GAS unsigned long long*)(WSP(bf16, WS_XN) + (size_t)m * DM) + F.lane;
#pragma unroll
            for (int j = 0; j < 8; ++j) o8[64 * j] = (unsigned long long)pk2(v[j].x, v[j].y) | ((unsigned long long)pk2(v[j].z, v[j].w) << 32); }
#pragma unroll
          for (int j = 0; j < 8; ++j) v[j] = vn[j]; } }
}

struct ConvItem { const float* W; bf16* WT; int ldw, ldt, k0, n0, add, kperm, gsel; };
__device__ __forceinline__ ConvItem conv_item(Frame& F, int it) {
    constexpr int I_POOL = 4 * 16, I_WOUT = 32 * 32, I_WPG = 32 * 32, I_WPLE = 4 * 32, I_EG = 64 * 256; ConvItem c; int r = it; c.add = -1; c.kperm = 0; c.gsel = -1;
    if (r < I_POOL) { const int g = r / 16, q = r % 16; c.W = F.w_pool + (size_t)g * PG * PG; c.ldw = PG; c.WT = WSP(bf16, WS_WPOOL) + (size_t)g * PG * PG; c.ldt = PG; c.k0 = 64 * (q / 4); c.n0 = 64 * (q % 4); return c; } r -= I_POOL;
    if (r < I_WOUT) { c.W = F.w_out; c.ldw = DM; c.WT = WSP(bf16, WS_WOUT); c.ldt = DM; c.k0 = 64 * (r / 32); c.n0 = 64 * (r % 32); c.kperm = 1; return c; } r -= I_WOUT;
    if (r < I_WPG) { c.W = F.w_pg; c.ldw = DM; c.WT = WSP(bf16, WS_WPG); c.ldt = DM; c.k0 = 64 * (r / 32); c.n0 = 64 * (r % 32); c.gsel = 1; return c; } r -= I_WPG;
    if (r < I_WPLE) { c.W = F.w_ple; c.ldw = DM; c.WT = WSP(bf16, WS_WPLE); c.ldt = PLE; c.k0 = 64 * (r / 32); c.n0 = 64 * (r % 32); return c; } r -= I_WPLE;
    if (r < 2 * I_EG) { const bool up = r >= I_EG; r -= up ? I_EG : 0; const int e = r / 256, q = r % 256;
        c.W = (up ? F.w_eu : F.w_eg) + (size_t)e * DM * DE; c.ldw = DE; c.WT = WSP(bf16, WS_WGU) + (size_t)e * 1024 * DM; c.ldt = DM; { const int g = q >> 3, w = q & 7; c.k0 = 64 * (4 * (g >> 2) + (w >> 1)); c.n0 = 64 * (2 * (g & 3) + (w & 1)); }        c.add = up ? 4 : 0; c.gsel = 0; return c; }
    r -= 2 * I_EG; { const int e = r / 256, q = r % 256;
        c.W = F.w_ed + (size_t)e * DE * DM; c.ldw = DM; c.WT = WSP(bf16, WS_WD) + (size_t)e * DM * DE; c.ldt = DE; { const int g = q >> 3, w = q & 7; c.k0 = 64 * (4 * (g >> 4) + (w >> 1)); c.n0 = 64 * (2 * (g & 15) + (w & 1)); } }
    return c;
}
struct RmAny { int add; __device__ __forceinline__ int operator()(int n) const { return add < 0 ? n : ((n >> 2) << 3) + (n & 3) + add; } };
struct KmAny { int on; __device__ __forceinline__ int operator()(int k) const { return (on && k < AW) ? ((k & ~127) + 32 * (k & 3) + ((k & 127) >> 2)) : k; } };
__device__ __forceinline__ void conv_experts(Frame& F, int part, int nparts) {
    LAS float* scr = (LAS float*)(F.lds + F.wave * 16640);
    constexpr int NITEMS = 4 * 16 + 32 * 32 + 32 * 32 + 4 * 32 + 3 * 64 * 256; const int step = nparts * NWAVES;
    LAS float* lg = (LAS float*)(F.lds + 143360);
    for (int i = F.tid; i < DM; i += NWAVES * 64) { lg[i] = F.g_ffn[i]; lg[DM + i] = F.g_ple[i]; }
    __syncthreads();
    int it = part * NWAVES + F.wave;
    f32x4 va[16], vb[16];
#define CV_LOAD(buf, idx) do { if ((idx) < NITEMS) { const ConvItem c_ = conv_item(F, (idx)); tr64_load(c_.W, c_.ldw, c_.k0, c_.n0, F.lane, buf, KmAny{c_.kperm}); } } while (0)
#define CV_FIN(buf, idx) do { const ConvItem c_ = conv_item(F, (idx)); tr64_finish(buf, c_.WT, c_.ldt, c_.k0, c_.n0, RmAny{c_.add}, scr, F.lane, lg, c_.gsel); } while (0)
    CV_LOAD(va, it);
    while (it < NITEMS) {
        CV_LOAD(vb, it + step); CV_FIN(va, it); it += step; if (it >= NITEMS) break;
        CV_LOAD(va, it + step); CV_FIN(vb, it); it += step;
    }
#undef CV_LOAD
#undef CV_FIN
}
struct SplitSched {
    pg8::TileOrder ord; const char* A; const char* Bt; size_t a_tile, b_tile; int NC, K1;
    __device__ __forceinline__ bool next(int i, pg8::Unit& u) const {
        int L;
        if (i < K1) L = i * ord.G + ord.c; else { if (ord.c < NC) return false; L = K1 * ord.G + (i - K1) * (ord.G - NC) + (ord.c - NC); }
        int pm, pn; if (!ord.map((long)L, pm, pn)) return false; u.pm = pm; u.pn = pn; u.x0 = 0; u.x1 = 0;
        u.a = A + (size_t)pm * a_tile; u.b = Bt + (size_t)pn * b_tile; return true; }
    __device__ __forceinline__ unsigned row_off(const pg8::Unit&, int) const { return 0u; }
};

struct DenseSched {
    pg8::TileOrder ord; const char* A; const char* Bt; size_t a_tile, b_tile; size_t a_pn_off;
    __device__ __forceinline__ bool next(int i, pg8::Unit& u) const { int pm, pn; if (!ord.tile(i, pm, pn)) return false; u.pm = pm; u.pn = pn; u.x0 = 0; u.x1 = 0;
        u.a = A + (size_t)pm * a_tile + (size_t)pn * a_pn_off; u.b = Bt + (size_t)pn * b_tile; return true; }
    __device__ __forceinline__ unsigned row_off(const pg8::Unit&, int) const { return 0u; }
};
struct MoeSched {
    int TT, NCT, G, c; const LAS int* tile_e; const char* A; const char* Bt; size_t b_exp, b_ct; size_t a_tile; const int* elist; unsigned a_row;
    __device__ __forceinline__ bool next(int i, pg8::Unit& u) const {
        const int L = i * G + c; if (L >= TT * NCT) return false; const int tile = L / NCT, ct = L % NCT; const int e = tile_e[tile];
        const int l0 = (tile - tile_e[MAXTILES + e]) * 256; const int nv = tile_e[MAXTILES + 160 + e] - l0;
        u.pm = nv < 256 ? nv : 256; u.pn = ct; u.x0 = tile * 256; u.x1 = e * T + l0; u.b = Bt + (size_t)e * b_exp + (size_t)ct * b_ct; u.a = A + (size_t)tile * a_tile; return true; }
    __device__ __forceinline__ unsigned row_off(const pg8::Unit& u, int r) const { const int s = elist[u.x1 + (r < u.pm ? r : u.pm - 1)]; return (unsigned)(s >> 1) * a_row; }
};
__device__ __forceinline__ int build_tile_table(Frame& F) {
    LAS int* tab = (LAS int*)(F.lds + TAB_OFF);
    __syncthreads();
    if (F.tid < 64) { const unsigned c = __hip_atomic_load(F.ctl + CW_ECNT + F.tid, RLX_AGENT); tab[MAXTILES + 80 + F.tid] = (int)((c + 255u) >> 8); tab[MAXTILES + 160 + F.tid] = (int)c; }
    __syncthreads();
    if (F.tid == 0) { int s = 0; for (int e = 0; e < 64; ++e) { tab[MAXTILES + e] = s; s += tab[MAXTILES + 80 + e]; } tab[MAXTILES + 64] = s; }
    __syncthreads();
    const int TT = tab[MAXTILES + 64];
    if (F.tid < MAXTILES) { int e = 0; for (int k = 1; k < 64; ++k) e += (tab[MAXTILES + k] <= F.tid) ? 1 : 0; tab[F.tid] = e; }
    __syncthreads();
    return TT;
}

using pg8::f32x4; using pg8::Unit; using pg8::cvt_pk_bf16; using pg8::u32x4; using pg8::u32x2;
template <bool NTS = false> struct EpiBf16T {
    static constexpr bool PERM = true; static constexpr int NST = 16;
    bf16* O; int ldc; int col_base;
    const float* rs;
    __device__ __forceinline__ void operator()(const f32x4 (&acc)[2][2][4][2], const Unit& u, int wr, int wc, int fr, int fq) const {
        const int row0 = u.pm * 256 + wr * 64 + fr, col0 = col_base + u.pn * 256 + wc * 32 + 8 * fq;
        float rsv[2][4];
#pragma unroll
        for (int ai = 0; ai < 2; ++ai)
#pragma unroll
            for (int m = 0; m < 4; ++m) rsv[ai][m] = rs[row0 + ai * 128 + m * 16];
#pragma unroll
        for (int ai = 0; ai < 2; ++ai)
#pragma unroll
            for (int m = 0; m < 4; ++m) { bf16* rowp = O + (size_t)(row0 + ai * 128 + m * 16) * ldc + col0; const float r_ = rsv[ai][m];
#pragma unroll
                for (int bj = 0; bj < 2; ++bj) { const f32x4 v0 = acc[ai][bj][m][0] * r_, v1 = acc[ai][bj][m][1] * r_;
                    u32x4 w; w.x = cvt_pk_bf16(v0[0], v0[1]); w.y = cvt_pk_bf16(v0[2], v0[3]); w.z = cvt_pk_bf16(v1[0], v1[1]); w.w = cvt_pk_bf16(v1[2], v1[3]);
                    if (NTS) { const bf16* p_ = rowp + bj * 128; asm volatile("global_store_dwordx4 %0, %1, off nt\n\ts_nop 1" :: "v"(p_), "v"(w) : "memory"); }
                    else *(GAS u32x4*)(rowp + bj * 128) = w; } }
    }
};
typedef EpiBf16T<false> EpiBf16;
#ifndef EPI_BATCH
#define EPI_BATCH 1
#endif
#if EPI_BATCH
#define EPI_SCHED_BARRIER __builtin_amdgcn_sched_barrier(0)
#else
#define EPI_SCHED_BARRIER do {} while (0)
#endif
struct EpiResBf16 {
    static constexpr bool PERM = true; static constexpr int NST = 16;
    const bf16* base; bf16* C; int ldc; float* ssq;
    __device__ __forceinline__ void operator()(const f32x4 (&acc)[2][2][4][2], const Unit& u, int wr, int wc, int fr, int fq) const {
        const int row0 = u.pm * 256 + wr * 64 + fr, col0 = u.pn * 256 + wc * 32 + 8 * fq;
        float* sq = ssq + (size_t)(4 * u.pn + wc) * T;
#pragma unroll
        for (int ai = 0; ai < 2; ++ai) {
            u32x4 bw[4][2];
#pragma unroll
            for (int m = 0; m < 4; ++m) { const size_t ro = (size_t)(row0 + ai * 128 + m * 16) * ldc + col0;
#pragma unroll
                for (int bj = 0; bj < 2; ++bj) bw[m][bj] = __builtin_nontemporal_load((const GAS u32x4*)(base + ro + bj * 128)); }
            EPI_SCHED_BARRIER;
#pragma unroll
            for (int m = 0; m < 4; ++m) { const size_t ro = (size_t)(row0 + ai * 128 + m * 16) * ldc + col0; float ss = 0.f;
#pragma unroll
                for (int bj = 0; bj < 2; ++bj) {
                    const u32x4 xw = bw[m][bj]; const f32x4 x0 = {bflo(xw.x), bfhi(xw.x), bflo(xw.y), bfhi(xw.y)}, x1 = {bflo(xw.z), bfhi(xw.z), bflo(xw.w), bfhi(xw.w)};
                    const f32x4 v0 = acc[ai][bj][m][0] + x0, v1 = acc[ai][bj][m][1] + x1;
                    ss += (v0[0] * v0[0] + v0[1] * v0[1]) + (v0[2] * v0[2] + v0[3] * v0[3]) + (v1[0] * v1[0] + v1[1] * v1[1]) + (v1[2] * v1[2] + v1[3] * v1[3]);
                    u32x4 w; w.x = cvt_pk_bf16(v0[0], v0[1]); w.y = cvt_pk_bf16(v0[2], v0[3]); w.z = cvt_pk_bf16(v1[0], v1[1]); w.w = cvt_pk_bf16(v1[2], v1[3]);
                    *(GAS u32x4*)(C + ro + bj * 128) = w; }
                ss += __shfl_xor(ss, 16); ss += __shfl_xor(ss, 32);
                if (fq == 0) sq[row0 + ai * 128 + m * 16] = ss; }
            EPI_SCHED_BARRIER;
        }
    }
};
struct EpiLogit {
    static constexpr bool PERM = false; static constexpr int NST = 16;
    float* C;
    __device__ __forceinline__ void operator()(const f32x4 (&acc)[2][2][4][2], const Unit& u, int wr, int wc, int fr, int fq) const {
        const int row0 = u.pm * 256 + wr * 64 + fr, col0 = wc * 32 + 4 * fq; float* Cb = C + (size_t)u.pn * T * 128;
#pragma unroll
        for (int ai = 0; ai < 2; ++ai)
#pragma unroll
            for (int m = 0; m < 4; ++m) { float* rowp = Cb + (size_t)(row0 + ai * 128 + m * 16) * 128 + col0;
#pragma unroll
                for (int n = 0; n < 2; ++n) *(GAS f32x4*)(rowp + n * 16) = acc[ai][0][m][n]; }
    }
};
struct EpiGU {
    static constexpr bool PERM = true; static constexpr int NST = 16;
    bf16* H; const float* ers;
    __device__ __forceinline__ void operator()(const f32x4 (&acc)[2][2][4][2], const Unit& u, int wr, int wc, int fr, int fq) const {
        const int row0 = u.x0 + wr * 64 + fr, col0 = u.pn * 128 + wc * 16 + 4 * fq;
        float rsv[2][4];
#pragma unroll
        for (int ai = 0; ai < 2; ++ai)
#pragma unroll
            for (int m = 0; m < 4; ++m) { const int r = wr * 64 + fr + ai * 128 + m * 16; rsv[ai][m] = ers[u.x1 + (r < u.pm ? r : u.pm - 1)]; }
#pragma unroll
        for (int ai = 0; ai < 2; ++ai)
#pragma unroll
            for (int m = 0; m < 4; ++m) { bf16* rowp = H + (size_t)(row0 + ai * 128 + m * 16) * DE + col0; const float rs = rsv[ai][m];
#pragma unroll
                for (int bj = 0; bj < 2; ++bj) { const f32x4 g = acc[ai][bj][m][0] * rs, up = acc[ai][bj][m][1] * rs; float h[4];
#pragma unroll
                    for (int j = 0; j < 4; ++j) h[j] = g[j] * __builtin_amdgcn_rcpf(1.0f + __expf(-g[j])) * up[j];
                    u32x2 w; w.x = cvt_pk_bf16(h[0], h[1]); w.y = cvt_pk_bf16(h[2], h[3]);
                    *(GAS u32x2*)(rowp + bj * 64) = w; } }
    }
};
struct EpiDown {
    static constexpr bool PERM = true; static constexpr int NST = 16;
    bf16* Y; const int* elist; const float* ewl; bf16* dummy;
    __device__ __forceinline__ void operator()(const f32x4 (&acc)[2][2][4][2], const Unit& u, int wr, int wc, int fr, int fq) const {
        const int col0 = u.pn * 256 + wc * 32 + 8 * fq;
        int sl[2][4]; float wv[2][4];
#pragma unroll
        for (int ai = 0; ai < 2; ++ai)
#pragma unroll
            for (int m = 0; m < 4; ++m) { const int r = wr * 64 + fr + ai * 128 + m * 16; const int ix = u.x1 + (r < u.pm ? r : u.pm - 1); const int s_ = elist[ix]; sl[ai][m] = r < u.pm ? s_ : -1; wv[ai][m] = ewl[ix]; }
#pragma unroll
        for (int ai = 0; ai < 2; ++ai)
#pragma unroll
            for (int m = 0; m < 4; ++m) { const int slot = sl[ai][m]; const float w = wv[ai][m]; const int r = wr * 64 + fr + ai * 128 + m * 16;
                bf16* rowp = (slot >= 0 ? Y + (size_t)slot * DM : dummy + (size_t)r * DM) + col0;
#pragma unroll
                for (int bj = 0; bj < 2; ++bj) { const f32x4 v0 = acc[ai][bj][m][0] * w, v1 = acc[ai][bj][m][1] * w;
                    u32x4 o; o.x = cvt_pk_bf16(v0[0], v0[1]); o.y = cvt_pk_bf16(v0[2], v0[3]); o.z = cvt_pk_bf16(v1[0], v1[1]); o.w = cvt_pk_bf16(v1[2], v1[3]);
                    __builtin_nontemporal_store(o, (GAS u32x4*)(rowp + bj * 128)); } }
    }
};
struct EpiPle {
    static constexpr bool PERM = true; static constexpr int NST = 16;
    const bf16* H2; bf16* H3; const bf16* PE; const float* bias; const float* rs;
    __device__ __forceinline__ void operator()(const f32x4 (&acc)[2][2][4][2], const Unit& u, int wr, int wc, int fr, int fq) const {
        const int row0 = u.pm * 256 + wr * 64 + fr, col0 = u.pn * 256 + wc * 32 + 8 * fq;
        f32x4 bv[2][2];
#pragma unroll
        for (int bj = 0; bj < 2; ++bj)
#pragma unroll
            for (int n = 0; n < 2; ++n) bv[bj][n] = *(const GAS f32x4*)(bias + col0 + bj * 128 + n * 4);
#pragma unroll
        for (int ai = 0; ai < 2; ++ai) {
            u32x4 hw[4][2], pw[4][2]; float rsv[4];
#pragma unroll
            for (int m = 0; m < 4; ++m) rsv[m] = rs[row0 + ai * 128 + m * 16];
#pragma unroll
            for (int m = 0; m < 4; ++m) { const size_t ro = (size_t)(row0 + ai * 128 + m * 16) * DM + col0;
#pragma unroll
                for (int bj = 0; bj < 2; ++bj) { const size_t o = ro + bj * 128; hw[m][bj] = __builtin_nontemporal_load((const GAS u32x4*)(H2 + o)); pw[m][bj] = __builtin_nontemporal_load((const GAS u32x4*)(PE + o)); } }
            EPI_SCHED_BARRIER;
#pragma unroll
            for (int m = 0; m < 4; ++m) { const size_t ro = (size_t)(row0 + ai * 128 + m * 16) * DM + col0;
#pragma unroll
                for (int bj = 0; bj < 2; ++bj) { const size_t o = ro + bj * 128; const u32x4 h = hw[m][bj], q = pw[m][bj];
                    const f32x4 a0 = acc[ai][bj][m][0] * rsv[m] + bv[bj][0], a1 = acc[ai][bj][m][1] * rsv[m] + bv[bj][1];
                    float r[8];
                    r[0] = bflo(h.x) + bflo(q.x) * __builtin_amdgcn_rcpf(1.0f + __expf(-a0[0])); r[1] = bfhi(h.x) + bfhi(q.x) * __builtin_amdgcn_rcpf(1.0f + __expf(-a0[1]));
                    r[2] = bflo(h.y) + bflo(q.y) * __builtin_amdgcn_rcpf(1.0f + __expf(-a0[2])); r[3] = bfhi(h.y) + bfhi(q.y) * __builtin_amdgcn_rcpf(1.0f + __expf(-a0[3]));
                    r[4] = bflo(h.z) + bflo(q.z) * __builtin_amdgcn_rcpf(1.0f + __expf(-a1[0])); r[5] = bfhi(h.z) + bfhi(q.z) * __builtin_amdgcn_rcpf(1.0f + __expf(-a1[1]));
                    r[6] = bflo(h.w) + bflo(q.w) * __builtin_amdgcn_rcpf(1.0f + __expf(-a1[2])); r[7] = bfhi(h.w) + bfhi(q.w) * __builtin_amdgcn_rcpf(1.0f + __expf(-a1[3]));
                    u32x4 w; w.x = cvt_pk_bf16(r[0], r[1]); w.y = cvt_pk_bf16(r[2], r[3]); w.z = cvt_pk_bf16(r[4], r[5]); w.w = cvt_pk_bf16(r[6], r[7]);
                    *(GAS u32x4*)(H3 + o) = w; } }
            EPI_SCHED_BARRIER;
        }
    }
};

__device__ __forceinline__ void row_load_bf(const bf16* row, int lane, float (&f)[4][8]) {
    const GAS v4u* r4 = (const GAS v4u*)row + lane;
#pragma unroll
    for (int j = 0; j < 4; ++j) { const v4u w = r4[64 * j];
        f[j][0] = bflo(w.x); f[j][1] = bfhi(w.x); f[j][2] = bflo(w.y); f[j][3] = bfhi(w.y); f[j][4] = bflo(w.z); f[j][5] = bfhi(w.z); f[j][6] = bflo(w.w); f[j][7] = bfhi(w.w); }
}
__device__ __forceinline__ void row_load_bf_nt(const bf16* row, int lane, float (&f)[4][8]) {
    const GAS v4u* r4 = (const GAS v4u*)row + lane;
#pragma unroll
    for (int j = 0; j < 4; ++j) { const v4u w = __builtin_nontemporal_load(r4 + 64 * j);
        f[j][0] = bflo(w.x); f[j][1] = bfhi(w.x); f[j][2] = bflo(w.y); f[j][3] = bfhi(w.y); f[j][4] = bflo(w.z); f[j][5] = bfhi(w.z); f[j][6] = bflo(w.w); f[j][7] = bfhi(w.w); }
}
__device__ __forceinline__ void row_ldp(const bf16* row, int lane, v4u (&w)[4]) {
    const GAS v4u* r4 = (const GAS v4u*)row + lane;
#pragma unroll
    for (int j = 0; j < 4; ++j) w[j] = r4[64 * j];
}
__device__ __forceinline__ void row_ldp_nt(const bf16* row, int lane, v4u (&w)[4]) {
    const GAS v4u* r4 = (const GAS v4u*)row + lane;
#pragma unroll
    for (int j = 0; j < 4; ++j) w[j] = __builtin_nontemporal_load(r4 + 64 * j);
}
__device__ __forceinline__ void row_unpack(const v4u (&w)[4], float (&f)[4][8]) {
#pragma unroll
    for (int j = 0; j < 4; ++j) { f[j][0] = bflo(w[j].x); f[j][1] = bfhi(w[j].x); f[j][2] = bflo(w[j].y); f[j][3] = bfhi(w[j].y); f[j][4] = bflo(w[j].z); f[j][5] = bfhi(w[j].z); f[j][6] = bflo(w[j].w); f[j][7] = bfhi(w[j].w); }
}
__device__ __forceinline__ float row_ss_bf(const float (&f)[4][8]) {
    float s = 0.f;
#pragma unroll
    for (int j = 0; j < 4; ++j)
#pragma unroll
        for (int k = 0; k < 8; ++k) s += f[j][k] * f[j][k];
    return wave_sum(s);
}
__device__ __forceinline__ void row_norm_bf_store(const float (&f)[4][8], float ss, const float* gain, bf16* orow, int lane) {
    const float r = 1.0f / sqrtf(ss * (1.f / DM) + EPS);
    GAS v4u* o4 = (GAS v4u*)orow + lane;
#pragma unroll
    for (int j = 0; j < 4; ++j) { const GAS f32x4* g4 = (const GAS f32x4*)(gain + (64 * j + lane) * 8); const f32x4 g0 = g4[0], g1 = g4[1]; v4u o;
        o.x = pk2(f[j][0] * r * g0.x, f[j][1] * r * g0.y); o.y = pk2(f[j][2] * r * g0.z, f[j][3] * r * g0.w);
        o.z = pk2(f[j][4] * r * g1.x, f[j][5] * r * g1.y); o.w = pk2(f[j][6] * r * g1.z, f[j][7] * r * g1.w); o4[64 * j] = o; }
}

template <int WIN>
__device__ __forceinline__ void z_load(const bf16* proj, int tp, int g, int lane, v4u (&w)[WIN]) {
    const int t = 2 * tp + (lane >> 5), c8 = g * PG + (lane & 31) * 8, pos = t & (SEQ - 1);
    const bf16* up = proj + (size_t)t * NIN + 3 * AW + c8;
#pragma unroll
    for (int d = 0; d < WIN; ++d) { const int dd = (d <= pos) ? d : 0; w[d] = *(const GAS v4u*)(up - (size_t)dd * NIN); }
}
template <int WIN>
__device__ __forceinline__ void z_fin(const v4u (&w)[WIN], bf16* Z, int tp, int g, int lane) {
    const int t = 2 * tp + (lane >> 5), c8 = g * PG + (lane & 31) * 8, pos = t & (SEQ - 1);
    float s[8];
#pragma unroll
    for (int j = 0; j < 8; ++j) s[j] = 0.f;
#pragma unroll
    for (int d = 0; d < WIN; ++d) { const float m = (d <= pos) ? 1.f : 0.f;
        s[0] += m * bflo(w[d].x); s[1] += m * bfhi(w[d].x); s[2] += m * bflo(w[d].y); s[3] += m * bfhi(w[d].y); s[4] += m * bflo(w[d].z); s[5] += m * bfhi(w[d].z); s[6] += m * bflo(w[d].w); s[7] += m * bfhi(w[d].w); }
    const int cnt = (pos + 1 < WIN) ? pos + 1 : WIN; const float inv = 1.0f / (float)cnt; v4u o;
    o.x = pk2(s[0] * inv - bflo(w[0].x), s[1] * inv - bfhi(w[0].x)); o.y = pk2(s[2] * inv - bflo(w[0].y), s[3] * inv - bfhi(w[0].y));
    o.z = pk2(s[4] * inv - bflo(w[0].z), s[5] * inv - bfhi(w[0].z)); o.w = pk2(s[6] * inv - bflo(w[0].w), s[7] * inv - bfhi(w[0].w));
    *(GAS v4u*)(Z + (size_t)t * PW + c8) = o;
}
__device__ __forceinline__ void p2_kmean_z(Frame& F) {
    const bf16* proj = WSP(bf16, WS_PROJ); float* kmean = WSP(float, WS_KMEAN);
    LAS float* scr = (LAS float*)F.lds;
    for (int it = F.vcu; it < BATCH * NBLK * NH; it += F.G) {
        const int h = it & 7, blk = (it >> 3) & 31, b = it >> 8;
        const GAS unsigned* src = (const GAS unsigned*)(proj + ((size_t)(b * SEQ + blk * MBLK + F.wave * 32)) * NIN + AW + h * HD) + F.lane;
        float s0 = 0.f, s1 = 0.f;
#pragma unroll
        for (int r = 0; r < 32; ++r) { const unsigned w = src[(size_t)r * (NIN / 2)]; s0 += bflo(w); s1 += bfhi(w); }
        __syncthreads();
        scr[F.wave * 128 + 2 * F.lane] = s0; scr[F.wave * 128 + 2 * F.lane + 1] = s1;
        __syncthreads();
        if (F.tid < 128) { float s = 0.f;
#pragma unroll
            for (int w = 0; w < 8; ++w) s += scr[w * 128 + F.tid];
            kmean[((size_t)(b * NH + h) * NBLK + blk) * HD + F.tid] = s * (1.f / MBLK); }
    }
    __syncthreads();
    const int gw = F.vcu * NWAVES + F.wave, NGW = F.G * NWAVES;
    bf16* Z = WSP(bf16, WS_Z);
    for (int tp = gw; tp < T / 2; tp += NGW) {
        v4u w2[2], w4[4], w8[8], w16[16];
        z_load<2>(proj, tp, 0, F.lane, w2); z_load<4>(proj, tp, 1, F.lane, w4); z_load<8>(proj, tp, 2, F.lane, w8); z_load<16>(proj, tp, 3, F.lane, w16);
        z_fin<2>(w2, Z, tp, 0, F.lane); z_fin<4>(w4, Z, tp, 1, F.lane); z_fin<8>(w8, Z, tp, 2, F.lane); z_fin<16>(w16, Z, tp, 3, F.lane);
    }
}

__device__ __forceinline__ float dot_row(const bf16* krow, const unsigned (&qp)[64]) {
    const GAS v4u* k4 = (const GAS v4u*)krow; float a0 = 0.f, a1 = 0.f;
#pragma unroll
    for (int c = 0; c < 16; ++c) { const v4u w = k4[c];
        a0 += bflo(w.x) * bflo(qp[4 * c]) + bflo(w.y) * bflo(qp[4 * c + 1]) + bflo(w.z) * bflo(qp[4 * c + 2]) + bflo(w.w) * bflo(qp[4 * c + 3]);
        a1 += bfhi(w.x) * bfhi(qp[4 * c]) + bfhi(w.y) * bfhi(qp[4 * c + 1]) + bfhi(w.z) * bfhi(qp[4 * c + 2]) + bfhi(w.w) * bfhi(qp[4 * c + 3]); }
    return a0 + a1;
}
__device__ __forceinline__ void attn_simple(Frame& F) {
    const bf16* proj = WSP(bf16, WS_PROJ); const float* kmean = WSP(float, WS_KMEAN); bf16* MIXB = WSP(bf16, WS_MIX);
    LAS unsigned* qs = (LAS unsigned*)(F.lds + F.wave * 256);
    const int gw = F.vcu * NWAVES + F.wave, NGW = F.G * NWAVES, lane = F.lane;
    const float scale = 0.08838834764831845f;
    for (int item = gw; item < T * NH; item += NGW) {
        const int h = item & 7, t = item >> 3, b = t >> 13, qpos = t & (SEQ - 1), own = qpos >> 8;
        const float slope = __builtin_bit_cast(float, (unsigned)(127 - (h + 1)) << 23);
        qs[lane] = ((const GAS unsigned*)(proj + (size_t)t * NIN + h * HD))[lane];
        LDS_WAIT();
        unsigned qp[64];
#pragma unroll
        for (int c = 0; c < 16; ++c) { const v4u w = *(const LAS v4u*)(qs + 4 * c); qp[4 * c] = w.x; qp[4 * c + 1] = w.y; qp[4 * c + 2] = w.z; qp[4 * c + 3] = w.w; }
        LDS_WAIT();
        float gate = -INFINITY;
        if (lane < own) { const GAS f32x4* km = (const GAS f32x4*)(kmean + ((size_t)(b * NH + h) * NBLK + lane) * HD); float a = 0.f;
#pragma unroll
            for (int c = 0; c < 32; ++c) { const f32x4 kv = km[c]; a += kv.x * bflo(qp[2 * c]) + kv.y * bfhi(qp[2 * c]) + kv.z * bflo(qp[2 * c + 1]) + kv.w * bfhi(qp[2 * c + 1]); }
            gate = a; }
        int sel[3] = {0, 0, 0};
#pragma unroll
        for (int r = 0; r < 3; ++r) if (r < own) { const float m = wave_max(gate); const unsigned long long bal = __ballot(gate == m); const int s = __ffsll((long long)bal) - 1; sel[r] = s; if (lane == s) gate = -INFINITY; }
        float sc[4][4];
#pragma unroll
        for (int s = 0; s < 4; ++s) { const bool valid = (s == 3) || (s < own); const int blk = (s == 3) ? own : sel[s];
#pragma unroll
            for (int i = 0; i < 4; ++i) { const int kpos = blk * MBLK + lane + 64 * i; float v = -INFINITY;
                if (valid) { const float d = dot_row(proj + (size_t)(b * SEQ + kpos) * NIN + AW + h * HD, qp); v = d * scale - slope * (float)(qpos - kpos); if (s == 3 && kpos > qpos) v = -INFINITY; }
                sc[s][i] = v; } }
        float mx = -INFINITY;
#pragma unroll
        for (int s = 0; s < 4; ++s)
#pragma unroll
            for (int i = 0; i < 4; ++i) mx = fmaxf(mx, sc[s][i]);
        mx = wave_max(mx);
        float ls = 0.f;
#pragma unroll
        for (int s = 0; s < 4; ++s)
#pragma unroll
            for (int i = 0; i < 4; ++i) { sc[s][i] = __expf(sc[s][i] - mx); ls += sc[s][i]; }
        ls = wave_sum(ls);
        float o0 = 0.f, o1 = 0.f;
#pragma unroll
        for (int s = 0; s < 4; ++s) { const bool valid = (s == 3) || (s < own); const int blk = (s == 3) ? own : sel[s];
            if (valid) {
#pragma unroll
                for (int i = 0; i < 4; ++i) { const GAS unsigned* vb = (const GAS unsigned*)(proj + (size_t)(b * SEQ + blk * MBLK + 64 * i) * NIN + 2 * AW + h * HD) + lane;
#pragma unroll 8
                    for (int kk = 0; kk < 64; ++kk) { const float pk = __builtin_bit_cast(float, __builtin_amdgcn_readlane(__builtin_bit_cast(int, sc[s][i]), kk));
                        const unsigned w = vb[(size_t)kk * (NIN / 2)]; o0 += pk * bflo(w); o1 += pk * bfhi(w); } } } }
        const float il = 1.0f / ls;
        ((GAS unsigned*)(MIXB + (size_t)t * DM + h * HD))[lane] = pk2(o0 * il, o1 * il);
    }
}

__device__ __forceinline__ void p4_mix_norm(Frame& F) {
    bf16* MIXB = WSP(bf16, WS_MIX); const bf16* OP = (const bf16*)F.out; const float* ML = (const float*)(F.ws + (1052u << 20));
    const int gw = F.vcu * NWAVES + F.wave, NGW = F.G * NWAVES, lane = F.lane, h = lane >> 3, sub = lane & 7;
    float gbv[16]; { const float* gb = F.beta_attn + h * HD + 4 * sub;
#pragma unroll
      for (int i = 0; i < 16; ++i) gbv[i] = gb[32 * (i & 3) + (i >> 2)]; }
    f32x4 gpv[4];
#pragma unroll
    for (int j = 0; j < 2; ++j) { const float* gp = F.pool_scale + (64 * j + lane) * 8; gpv[2 * j] = *(const GAS f32x4*)gp; gpv[2 * j + 1] = *(const GAS f32x4*)(gp + 4); }
    v4u pa[4][2], npa[4][2]; f32x4 ml0, ml1, nml0, nml1; v4u pw0, pw1, npw0, npw1;
#define MIX_LOAD(mm, PA, M0, M1, W0, W1) do { const size_t rec_ = (size_t)(mm) * NH + h; \
        _Pragma("unroll") for (int k = 0; k < 4; ++k) { const GAS v4u* src = (const GAS v4u*)(OP + (rec_ * 4 + k) * HD + sub * 16); PA[k][0] = __builtin_nontemporal_load(src); PA[k][1] = __builtin_nontemporal_load(src + 1); }     \
        const GAS f32x4* mlp = (const GAS f32x4*)(ML + rec_ * 8); M0 = __builtin_nontemporal_load(mlp); M1 = __builtin_nontemporal_load(mlp + 1);         \
        const GAS v4u* pr_ = (const GAS v4u*)(MIXB + (size_t)(mm) * DM + AW) + lane; W0 = pr_[0]; W1 = pr_[64]; } while (0)
    MIX_LOAD(gw, pa, ml0, ml1, pw0, pw1); VM_WAIT();
    for (int m = gw; m < T; m += NGW) {
        const int blk = (m & (SEQ - 1)) >> 8, nv = blk < 3 ? blk : 3;
        { const int mn = (m + NGW < T) ? m + NGW : m; MIX_LOAD(mn, npa, nml0, nml1, npw0, npw1); }
        GAS v4u* prow = (GAS v4u*)(MIXB + (size_t)m * DM + AW) + lane;
        const float mk[4] = {nv > 0 ? ml0.x : -1e30f, nv > 1 ? ml0.z : -1e30f, nv > 2 ? ml1.x : -1e30f, ml1.z};
        const float lk[4] = {nv > 0 ? ml0.y : 0.f, nv > 1 ? ml0.w : 0.f, nv > 2 ? ml1.y : 0.f, ml1.w};
        const float M = fmaxf(fmaxf(mk[0], mk[1]), fmaxf(mk[2], mk[3]));
        float e[4]; float L = 0.f;
#pragma unroll
        for (int k = 0; k < 4; ++k) { e[k] = lk[k] * __builtin_amdgcn_exp2f(mk[k] - M); L += e[k]; }
        const float iL = 1.0f / L;
        float f[16];
#pragma unroll
        for (int i = 0; i < 16; ++i) f[i] = 0.f;
#pragma unroll
        for (int k = 0; k < 4; ++k) { const bool ok = (k == 3) || (k < nv); const float w = e[k] * iL;
#pragma unroll
            for (int q = 0; q < 2; ++q) { const v4u x = pa[k][q]; const unsigned x0 = ok ? x.x : 0u, x1 = ok ? x.y : 0u, x2 = ok ? x.z : 0u, x3 = ok ? x.w : 0u;
                f[8 * q + 0] += w * bflo(x0); f[8 * q + 1] += w * bfhi(x0); f[8 * q + 2] += w * bflo(x1); f[8 * q + 3] += w * bfhi(x1);
                f[8 * q + 4] += w * bflo(x2); f[8 * q + 5] += w * bfhi(x2); f[8 * q + 6] += w * bflo(x3); f[8 * q + 7] += w * bfhi(x3); } }
        float ssa = 0.f;
#pragma unroll
        for (int i = 0; i < 16; ++i) { f[i] = bflo(f2bf(f[i]) ); ssa += f[i] * f[i]; }
        float pf[2][8]; float ssp = 0.f;
        { const v4u w[2] = {pw0, pw1};
#pragma unroll
          for (int j = 0; j < 2; ++j) { pf[j][0] = bflo(w[j].x); pf[j][1] = bfhi(w[j].x); pf[j][2] = bflo(w[j].y); pf[j][3] = bfhi(w[j].y); pf[j][4] = bflo(w[j].z); pf[j][5] = bfhi(w[j].z); pf[j][6] = bflo(w[j].w); pf[j][7] = bfhi(w[j].w);
#pragma unroll
              for (int k = 0; k < 8; ++k) ssp += pf[j][k] * pf[j][k]; } }
        ssa = wave_sum(ssa); ssp = wave_sum(ssp);
        const float ra = 1.0f / sqrtf(ssa * (1.f / AW) + EPS), rp = 1.0f / sqrtf(ssp * (1.f / PW) + EPS);
        { float o[16];
#pragma unroll
          for (int i = 0; i < 16; ++i) o[i] = f[i] * ra * gbv[i];
          GAS v4u* dst = (GAS v4u*)(MIXB + (size_t)m * DM + h * HD + sub * 16); v4u o0, o1;
          o0.x = pk2(o[0], o[1]); o0.y = pk2(o[2], o[3]); o0.z = pk2(o[4], o[5]); o0.w = pk2(o[6], o[7]); o1.x = pk2(o[8], o[9]); o1.y = pk2(o[10], o[11]); o1.z = pk2(o[12], o[13]); o1.w = pk2(o[14], o[15]);
          dst[0] = o0; dst[1] = o1; }
#pragma unroll
        for (int j = 0; j < 2; ++j) { const f32x4 g0 = gpv[2 * j], g1 = gpv[2 * j + 1]; v4u o;
            o.x = pk2(pf[j][0] * rp * g0.x, pf[j][1] * rp * g0.y); o.y = pk2(pf[j][2] * rp * g0.z, pf[j][3] * rp * g0.w);
            o.z = pk2(pf[j][4] * rp * g1.x, pf[j][5] * rp * g1.y); o.w = pk2(pf[j][6] * rp * g1.z, pf[j][7] * rp * g1.w);
            prow[64 * j] = o; }
#pragma unroll
        for (int k = 0; k < 4; ++k) { pa[k][0] = npa[k][0]; pa[k][1] = npa[k][1]; }
        ml0 = nml0; ml1 = nml1; pw0 = npw0; pw1 = npw1;
    }
#undef MIX_LOAD
}

__device__ __forceinline__ void gain_load(const float* gain, int lane, f32x4 (&g)[8]) {
#pragma unroll
    for (int j = 0; j < 4; ++j) { const GAS f32x4* g4 = (const GAS f32x4*)(gain + (64 * j + lane) * 8); g[2 * j] = g4[0]; g[2 * j + 1] = g4[1]; }
}
__device__ __forceinline__ void row_norm_bf_store_g(const float (&f)[4][8], float ss, const f32x4 (&g)[8], bf16* orow, int lane) {
    const float r = 1.0f / sqrtf(ss * (1.f / DM) + EPS);
    GAS v4u* o4 = (GAS v4u*)orow + lane;
#pragma unroll
    for (int j = 0; j < 4; ++j) { const f32x4 g0 = g[2 * j], g1 = g[2 * j + 1]; v4u o;
        o.x = pk2(f[j][0] * r * g0.x, f[j][1] * r * g0.y); o.y = pk2(f[j][2] * r * g0.z, f[j][3] * r * g0.w);
        o.z = pk2(f[j][4] * r * g1.x, f[j][5] * r * g1.y); o.w = pk2(f[j][6] * r * g1.z, f[j][7] * r * g1.w); o4[64 * j] = o; }
}
__device__ __forceinline__ void p6_norm_f(Frame& F) {
    const int gw = F.vcu * NWAVES + F.wave, NGW = F.G * NWAVES; const bf16* HB = (const bf16*)F.out; float* rsf = WSP(float, WS_RSF);
    v4u cur[4]; row_ldp(HB + (size_t)gw * DM, F.lane, cur); VM_WAIT();
    for (int m = gw; m < T; m += NGW) { const int mn = (m + NGW < T) ? m + NGW : m; v4u nx[4]; row_ldp(HB + (size_t)mn * DM, F.lane, nx);
        float f[4][8]; row_unpack(cur, f); const float ss = row_ss_bf(f); if (F.lane == 0) rsf[m] = 1.0f / sqrtf(ss * (1.f / DM) + EPS);
#pragma unroll
        for (int j = 0; j < 4; ++j) cur[j] = nx[j]; }
}

__device__ __forceinline__ void p8_route(Frame& F) {
    const float* LG = WSP(float, WS_LOGIT); int* elist = (int*)(F.ws + WS_ROUTE + RT_ELIST); float* ewl = (float*)(F.ws + WS_ROUTE + RT_EWL);
    LAS unsigned* hist = (LAS unsigned*)(F.lds); LAS unsigned* ebase = hist + 64;
    constexpr int CH = NWAVES * 64;
    for (int c0 = F.vcu * CH; c0 < T; c0 += F.G * CH) {
        __syncthreads();
        if (F.tid < 64) hist[F.tid] = 0u;
        __syncthreads();
        const int t = c0 + F.tid;
        const float* l = LG + (size_t)t * 128; const float* l2 = l + (size_t)T * 128;
        float rs; { const float* sq = WSP(float, WS_SSQ) + t; float a0 = 0.f, a1 = 0.f, a2 = 0.f, a3 = 0.f;
#pragma unroll
          for (int k = 0; k < 32; k += 4) { a0 += sq[(size_t)k * T]; a1 += sq[(size_t)(k + 1) * T]; a2 += sq[(size_t)(k + 2) * T]; a3 += sq[(size_t)(k + 3) * T]; }
          rs = 1.0f / sqrtf(((a0 + a1) + (a2 + a3)) * (1.f / DM) + EPS); }
        float lg[8]; float gm = -INFINITY; int gi = 0;
#pragma unroll
        for (int j = 0; j < 8; ++j) { lg[j] = (l[j] + l2[j]) * rs + F.b_rg[j]; if (lg[j] > gm) { gm = lg[j]; gi = j; } }
        float gs = 0.f;
#pragma unroll
        for (int j = 0; j < 8; ++j) gs += __expf(lg[j] - gm);
        const float gval = 1.0f / gs;
        float le[8]; float em = -INFINITY;
#pragma unroll
        for (int j = 0; j < 8; ++j) { le[j] = (l[8 + gi * 8 + j] + l2[8 + gi * 8 + j]) * rs + F.b_re[gi * 8 + j]; em = fmaxf(em, le[j]); }
        float es = 0.f;
#pragma unroll
        for (int j = 0; j < 8; ++j) { le[j] = __expf(le[j] - em); es += le[j]; }
        float v1 = -1.f, v2 = -1.f; int i1 = 0, i2 = 0;
#pragma unroll
        for (int j = 0; j < 8; ++j) { const float pv = le[j] / es; if (pv > v1) { v2 = v1; i2 = i1; v1 = pv; i1 = j; } else if (pv > v2) { v2 = pv; i2 = j; } }
        const float inv = 1.0f / (v1 + v2);
        const int e1 = gi * 8 + i1, e2 = gi * 8 + i2;
        const unsigned r1 = __hip_atomic_fetch_add(hist + e1, 1u, __ATOMIC_RELAXED, __HIP_MEMORY_SCOPE_WORKGROUP), r2 = __hip_atomic_fetch_add(hist + e2, 1u, __ATOMIC_RELAXED, __HIP_MEMORY_SCOPE_WORKGROUP);
        __syncthreads();
        if (F.tid < 64) { const unsigned c = hist[F.tid]; ebase[F.tid] = c ? atomicAdd((unsigned*)(F.ctl + CW_ECNT + F.tid), c) : 0u; }
        __syncthreads();
        const int k1 = (int)(ebase[e1] + r1), k2 = (int)(ebase[e2] + r2);
        elist[e1 * T + k1] = 2 * t; ewl[e1 * T + k1] = gval * (v1 * inv); elist[e2 * T + k2] = 2 * t + 1; ewl[e2 * T + k2] = gval * (v2 * inv);
        { float* ers = WSP(float, WS_ERS); ers[e1 * T + k1] = rs; ers[e2 * T + k2] = rs; }
    }
    __syncthreads();
}
__device__ __forceinline__ void p12_combine(Frame& F) {
    const bf16* Y = WSP(bf16, WS_PROJ); bf16* HB = (bf16*)F.out;
    const int gw = F.vcu * NWAVES + F.wave, NGW = F.G * NWAVES, lane = F.lane;
    v4u cf[4], c0[4], c1[4]; row_ldp_nt(HB + (size_t)gw * DM, lane, cf); row_ldp_nt(Y + (size_t)(2 * gw) * DM, lane, c0); row_ldp_nt(Y + (size_t)(2 * gw + 1) * DM, lane, c1); VM_WAIT();
    for (int m = gw; m < T; m += NGW) { const int mn = (m + NGW < T) ? m + NGW : m; bf16* hrow = HB + (size_t)m * DM;
        v4u nf[4], n0[4], n1[4]; row_ldp_nt(HB + (size_t)mn * DM, lane, nf); row_ldp_nt(Y + (size_t)(2 * mn) * DM, lane, n0); row_ldp_nt(Y + (size_t)(2 * mn + 1) * DM, lane, n1);
        float f[4][8], y0[4][8], y1[4][8]; row_unpack(cf, f); row_unpack(c0, y0); row_unpack(c1, y1);
        GAS v4u* o4 = (GAS v4u*)hrow + lane;
#pragma unroll
        for (int j = 0; j < 4; ++j) {
#pragma unroll
            for (int k = 0; k < 8; ++k) f[j][k] += y0[j][k] + y1[j][k];
            v4u o; o.x = pk2(f[j][0], f[j][1]); o.y = pk2(f[j][2], f[j][3]); o.z = pk2(f[j][4], f[j][5]); o.w = pk2(f[j][6], f[j][7]); o4[64 * j] = o; }
        const float ss = row_ss_bf(f); if (lane == 0) WSP(float, WS_RS3)[m] = 1.0f / sqrtf(ss * (1.f / DM) + EPS);
#pragma unroll
        for (int j = 0; j < 4; ++j) { cf[j] = nf[j]; c0[j] = n0[j]; c1[j] = n1[j]; } }
}
__device__ __forceinline__ void p15_final(Frame& F) {
    const bf16* H3 = WSP(bf16, WS_PROJ);
    const int gw = F.vcu * NWAVES + F.wave, NGW = F.G * NWAVES, lane = F.lane;
    f32x4 gn[8]; gain_load(F.g_final, lane, gn);
    v4u cur[4]; row_ldp_nt(H3 + (size_t)gw * DM, lane, cur); VM_WAIT();
    for (int m = gw; m < T; m += NGW) { const int mn = (m + NGW < T) ? m + NGW : m; v4u nx[4]; row_ldp_nt(H3 + (size_t)mn * DM, lane, nx); float f[4][8]; row_unpack(cur, f); const float ss = row_ss_bf(f);
        const float r = 1.0f / sqrtf(ss * (1.f / DM) + EPS); float* orow = F.out + (size_t)m * DM;
#pragma unroll
        for (int j = 0; j < 4; ++j) { const int col = (64 * j + lane) * 8; const f32x4 g0 = gn[2 * j], g1 = gn[2 * j + 1];
            f32x4 o0, o1; o0.x = f[j][0] * r * g0.x; o0.y = f[j][1] * r * g0.y; o0.z = f[j][2] * r * g0.z; o0.w = f[j][3] * r * g0.w;
            o1.x = f[j][4] * r * g1.x; o1.y = f[j][5] * r * g1.y; o1.z = f[j][6] * r * g1.z; o1.w = f[j][7] * r * g1.w;
            __builtin_nontemporal_store(o0, (GAS f32x4*)(orow + col)); __builtin_nontemporal_store(o1, (GAS f32x4*)(orow + col + 4)); }
#pragma unroll
        for (int j = 0; j < 4; ++j) cur[j] = nx[j]; }
}

constexpr int CW_ACNT = 32768;
constexpr int LISTCAP = SEQ * 31 - MBLK * (31 * 32 / 2);
__host__ __device__ constexpr int list_base(int j) { return SEQ * j - MBLK * (j * (j + 1) / 2); }
constexpr size_t WS_ALIST = 1035 * MiB;
constexpr size_t WS_ML = 1052 * MiB;
constexpr size_t WS_END2 = 1097 * MiB;
constexpr int ATAB_OFF = TAB_OFF;

namespace att {
using bf16x8 = __attribute__((ext_vector_type(8))) short;
using s16x4  = __attribute__((ext_vector_type(4))) short;
using f32x16 = __attribute__((ext_vector_type(16))) float;
using u32x4  = __attribute__((ext_vector_type(4))) unsigned;
constexpr int D = 128, NW = 8, QBLK = 32, KVBLK = 64, LDK = NIN;
constexpr float SCALE = 0.088388347648318440f;
constexpr float THR = 8.f;
constexpr float C = SCALE * 1.4426950408889634f;
constexpr size_t SHM_V = KVBLK * D * 2, SHM_K = KVBLK * D * 2;
constexpr int WS_OFF = 2 * SHM_V + 2 * SHM_K;
#define KSWZ(row, colB) ((row) * 256 + ((colB) ^ (((row) & 7) << 4)))
#define SBAR() __builtin_amdgcn_sched_barrier(0)
__device__ __forceinline__ int crow(int r, int hi) { return (r & 3) + 8 * (r >> 2) + 4 * hi; }
__device__ __forceinline__ unsigned cvtpk(float lo, float hi) { unsigned r; asm volatile("v_cvt_pk_bf16_f32 %0, %1, %2" : "=v"(r) : "v"(lo), "v"(hi)); return r; }

__device__ __forceinline__ void partialSM(f32x16& p0, f32x16& p1, float& m_reg, float& mn, float& alpha) {
  float pmax = p0[0];
#pragma unroll
  for (int r = 1; r < 16; ++r) pmax = fmaxf(pmax, p0[r]);
#pragma unroll
  for (int r = 0; r < 16; ++r) pmax = fmaxf(pmax, p1[r]);
  { auto rr = __builtin_amdgcn_permlane32_swap(__float_as_uint(pmax), __float_as_uint(pmax), false, false);
    pmax = fmaxf(__uint_as_float(rr[0]), __uint_as_float(rr[1])); }
  { const bool keep = (pmax - m_reg <= THR / SCALE); mn = keep ? m_reg : pmax; alpha = keep ? 1.f : __builtin_amdgcn_exp2f((m_reg - mn) * C); m_reg = mn; }
  float mnC = -mn * C;
#pragma unroll
  for (int r = 0; r < 16; ++r) p0[r] = fmaf(p0[r], C, mnC);
#pragma unroll
  for (int r = 0; r < 16; ++r) p1[r] = fmaf(p1[r], C, mnC);
#pragma unroll
  for (int r = 0; r < 16; ++r) p0[r] = __builtin_amdgcn_exp2f(p0[r]);
}
__device__ __forceinline__ void finishSM(f32x16& p0, f32x16& p1, float alpha, float& l_reg, bf16x8& pa0, bf16x8& pa1, bf16x8& pa2, bf16x8& pa3) {
#pragma unroll
  for (int r = 0; r < 16; ++r) p1[r] = __builtin_amdgcn_exp2f(p1[r]);
  float ps = 0;
#pragma unroll
  for (int r = 0; r < 16; ++r) ps += p0[r];
#pragma unroll
  for (int r = 0; r < 16; ++r) ps += p1[r];
  { auto rr = __builtin_amdgcn_permlane32_swap(__float_as_uint(ps), __float_as_uint(ps), false, false);
    ps = __uint_as_float(rr[0]) + __uint_as_float(rr[1]); }
  l_reg = l_reg * alpha + ps;
#define PK4(P, BASE, OUT) do { unsigned a0 = cvtpk(P[BASE + 0], P[BASE + 1]), a1 = cvtpk(P[BASE + 2], P[BASE + 3]);   \
    unsigned b0 = cvtpk(P[BASE + 4], P[BASE + 5]), b1 = cvtpk(P[BASE + 6], P[BASE + 7]);                              \
    auto r0 = __builtin_amdgcn_permlane32_swap(a0, b0, false, false); auto r1 = __builtin_amdgcn_permlane32_swap(a1, b1, false, false); \
    u32x4 w = {r0[0], r1[0], r0[1], r1[1]}; OUT = *reinterpret_cast<bf16x8*>(&w); } while (0)
  PK4(p0, 0, pa0); PK4(p0, 8, pa1); PK4(p1, 0, pa2); PK4(p1, 8, pa3);
#undef PK4
}
template <bool OWN>
__device__ __forceinline__ void qkt(f32x16& p0, f32x16& p1, const char* Ks, const bf16x8* qr, int r32, int hi, float ks, float kbase, int qrel) {
#pragma unroll
  for (int r = 0; r < 16; ++r) { p0[r] = fmaf(ks, (float)((r & 3) + 8 * (r >> 2)), kbase); p1[r] = fmaf(ks, (float)(32 + (r & 3) + 8 * (r >> 2)), kbase); }
#pragma unroll
  for (int d0 = 0; d0 < 8; ++d0) { int cb = (d0 * 16 + hi * 8) * 2;
    bf16x8 b0 = *reinterpret_cast<const bf16x8*>(Ks + KSWZ(r32, cb));
    bf16x8 b1 = *reinterpret_cast<const bf16x8*>(Ks + KSWZ(32 + r32, cb));
    p0 = __builtin_amdgcn_mfma_f32_32x32x16_bf16(b0, qr[d0], p0, 0, 0, 0);
    p1 = __builtin_amdgcn_mfma_f32_32x32x16_bf16(b1, qr[d0], p1, 0, 0, 0); }
  if constexpr (OWN) {
#pragma unroll
    for (int r = 0; r < 16; ++r) { if (((r & 3) + 8 * (r >> 2)) > qrel) p0[r] = -1e30f; if ((32 + (r & 3) + 8 * (r >> 2)) > qrel) p1[r] = -1e30f; }
  }
}
__device__ __forceinline__ int v_st(int k, int c) { const int kk = (k & ~0xC) | ((k & 4) << 1) | ((k & 8) >> 1); return ((kk >> 3) * 4 + (c >> 5)) * 512 + ((kk & 7) * 32 + (c & 31)) * 2; }
__device__ __forceinline__ int v_rd_base(int lane) { return ((lane & 3) << 3) | (((lane >> 2) & 3) << 6) | (((lane >> 4) & 1) << 5) | (((lane >> 5) & 1) << 8); }
constexpr int v_rd_off(int d0, int ks, int half) { return d0 * 512 + ks * 4096 + half * 2048; }
template <int OFF> __device__ __forceinline__ s16x4 tr_read(int vb) {
  s16x4 r; asm volatile("ds_read_b64_tr_b16 %0, %1 offset:%2" : "=&v"(r) : "v"(vb), "i"(OFF) : "memory"); return r;
}
template <int D0> __device__ __forceinline__ void pv_one(f32x16& od, int vb, bf16x8 pa0, bf16x8 pa1, bf16x8 pa2, bf16x8 pa3) {
  const s16x4 l0 = tr_read<v_rd_off(D0, 0, 0)>(vb), h0 = tr_read<v_rd_off(D0, 0, 1)>(vb), l1 = tr_read<v_rd_off(D0, 1, 0)>(vb), h1 = tr_read<v_rd_off(D0, 1, 1)>(vb);
  const s16x4 l2 = tr_read<v_rd_off(D0, 2, 0)>(vb), h2 = tr_read<v_rd_off(D0, 2, 1)>(vb), l3 = tr_read<v_rd_off(D0, 3, 0)>(vb), h3 = tr_read<v_rd_off(D0, 3, 1)>(vb);
  asm volatile("s_waitcnt lgkmcnt(0)" ::: "memory"); SBAR();
#define PK(L, H) (bf16x8){L[0], L[1], L[2], L[3], H[0], H[1], H[2], H[3]}
  od = __builtin_amdgcn_mfma_f32_32x32x16_bf16(pa0, PK(l0, h0), od, 0, 0, 0);
  od = __builtin_amdgcn_mfma_f32_32x32x16_bf16(pa1, PK(l1, h1), od, 0, 0, 0);
  od = __builtin_amdgcn_mfma_f32_32x32x16_bf16(pa2, PK(l2, h2), od, 0, 0, 0);
  od = __builtin_amdgcn_mfma_f32_32x32x16_bf16(pa3, PK(l3, h3), od, 0, 0, 0);
#undef PK
}
__device__ __forceinline__ void pv_d0(f32x16* o, int vb, bf16x8 pa0, bf16x8 pa1, bf16x8 pa2, bf16x8 pa3) {
  pv_one<0>(o[0], vb, pa0, pa1, pa2, pa3); pv_one<1>(o[1], vb, pa0, pa1, pa2, pa3); pv_one<2>(o[2], vb, pa0, pa1, pa2, pa3); pv_one<3>(o[3], vb, pa0, pa1, pa2, pa3);
}

constexpr int KV_K_OFF = 0, KV_V_OFF = 65536, WSCR_OFF = 147456;
__device__ __forceinline__ void kv_load_block(const bf16* __restrict__ proj, int b, int h, int blk, char* lds) {
  const int tid = threadIdx.x, sr = tid >> 4, sc = (tid & 15) * 8;
  const bf16* Kh = proj + ((size_t)b * SEQ + (size_t)blk * MBLK) * NIN + AW + h * HD;
  const bf16* Vh = Kh + AW;
  bf16x8 kr[8], vr[8];
#pragma unroll
  for (int i = 0; i < 8; ++i) { kr[i] = *reinterpret_cast<const bf16x8*>(&Kh[(size_t)(sr + 32 * i) * LDK + sc]); vr[i] = *reinterpret_cast<const bf16x8*>(&Vh[(size_t)(sr + 32 * i) * LDK + sc]); }
  __syncthreads();
#pragma unroll
  for (int i = 0; i < 8; ++i) { const int row = sr + 32 * i, kt = row >> 6, r = row & 63;
    *(bf16x8*)(lds + KV_K_OFF + kt * 16384 + KSWZ(r, sc * 2)) = kr[i];
    *(bf16x8*)(lds + KV_V_OFF + kt * 16384 + v_st(r, sc)) = vr[i]; }
  __syncthreads();
}
__device__ __forceinline__ void ld_q(const bf16* __restrict__ proj, int b, int h, int qpos, int hi, bf16x8 (&qr)[8]) {
  const bf16* Qw = proj + ((size_t)b * SEQ + qpos) * NIN + h * HD + hi * 8;
#pragma unroll
  for (int d0 = 0; d0 < 8; ++d0) qr[d0] = *reinterpret_cast<const bf16x8*>(Qw + d0 * 16);
}
template <bool OWN, int NT>
__device__ __forceinline__ void wave_group(int b, int h, int blk, int g, int qpos, int rank, bool valid, const bf16x8 (&qr)[8],
                                           bf16* __restrict__ OP, float* __restrict__ ML, char* lds) {
  const int tid = threadIdx.x, wid = tid >> 6; int lane = tid & 63;
  asm volatile("" : "+v"(lane));
  const int r32 = lane & 31, hi = lane >> 5;
  const char* K_lds = lds + KV_K_OFF;
  float* ws = (float*)(lds + WSCR_OFF) + wid * 256;
  float* li_l = ws; float* al_l = ws + 32; int* dst_l = (int*)(ws + 128);
  const float slope = __builtin_bit_cast(float, (unsigned)(127 - (h + 1)) << 23);
  const float ks = slope * (1.0f / SCALE);
  const int qi = g * QBLK + r32;
  const size_t tok = (size_t)b * SEQ + qpos;
  float m_reg = -1e30f, l_reg = 0; f32x16 o[4] = {};
  const int vb0 = (int)(uintptr_t)(lds + KV_V_OFF) + v_rd_base(lane);
#define RESC(a) do { if (__any((a) < 1.f)) { if (hi == 0) al_l[r32] = (a); asm volatile("s_waitcnt lgkmcnt(0)" ::: "memory"); \
    _Pragma("unroll") for (int d = 0; d < 4; ++d) _Pragma("unroll") for (int r = 0; r < 16; ++r) o[d][r] *= al_l[crow(r, hi)]; } } while (0)
#define KBASE(kt) (ks * (float)((kt) * 64 + 4 * hi))
#define QREL(kt) (qi - 64 * (kt) - 4 * hi)
  bf16x8 pa0, pa1, pa2, pa3;
  {
    f32x16 pA0, pA1, pB0, pB1; float mnA, mnB, alA, alB;
#define QK(P0, P1, t) qkt<OWN>(P0, P1, K_lds + (t) * 16384, qr, r32, hi, ks, KBASE(t), QREL(t))
#define PV(t) pv_d0(o, vb0 + (t) * 16384, pa0, pa1, pa2, pa3)
    QK(pA0, pA1, NT - 1); partialSM(pA0, pA1, m_reg, mnA, alA);
    if constexpr (NT >= 2) {
      SBAR(); QK(pB0, pB1, NT - 2); finishSM(pA0, pA1, alA, l_reg, pa0, pa1, pa2, pa3); SBAR(); PV(NT - 1); partialSM(pB0, pB1, m_reg, mnB, alB); RESC(alB);
      if constexpr (NT >= 3) {
        SBAR(); QK(pA0, pA1, NT - 3); finishSM(pB0, pB1, alB, l_reg, pa0, pa1, pa2, pa3); SBAR(); PV(NT - 2); partialSM(pA0, pA1, m_reg, mnA, alA); RESC(alA);
        if constexpr (NT >= 4) {
          SBAR(); QK(pB0, pB1, NT - 4); finishSM(pA0, pA1, alA, l_reg, pa0, pa1, pa2, pa3); SBAR(); PV(NT - 3); partialSM(pB0, pB1, m_reg, mnB, alB); RESC(alB);
          finishSM(pB0, pB1, alB, l_reg, pa0, pa1, pa2, pa3); SBAR(); PV(0);
        } else { finishSM(pA0, pA1, alA, l_reg, pa0, pa1, pa2, pa3); SBAR(); PV(0); }
      } else { finishSM(pB0, pB1, alB, l_reg, pa0, pa1, pa2, pa3); SBAR(); PV(0); }
    } else { finishSM(pA0, pA1, alA, l_reg, pa0, pa1, pa2, pa3); SBAR(); PV(0); }
#undef QK
#undef PV
  }
  const float mlog = m_reg * C + 1.4426950408889634f * slope * (float)(blk * MBLK - qpos);
  {
    const int dst = valid ? (int)((tok * NH + h) * 4 + (OWN ? 3 : rank)) : -1;
    if (hi == 0) { li_l[r32] = l_reg; dst_l[r32] = dst; if (valid) { v2u t; t.x = __builtin_bit_cast(unsigned, mlog); t.y = __builtin_bit_cast(unsigned, l_reg); *(GAS v2u*)(ML + 2 * (size_t)dst) = t; } }
    asm volatile("s_waitcnt lgkmcnt(0)" ::: "memory");
#pragma unroll
    for (int r = 0; r < 16; ++r) { const int row = crow(r, hi); const float il = __builtin_amdgcn_rcpf(li_l[row]); const int d = dst_l[row];
      if (d >= 0) { v2u w; w.x = cvtpk(o[0][r] * il, o[1][r] * il); w.y = cvtpk(o[2][r] * il, o[3][r] * il); *(GAS v2u*)(OP + (size_t)d * HD + r32 * 4) = w; } }
  }
  asm volatile("s_waitcnt lgkmcnt(0)" ::: "memory");
#undef RESC
#undef KBASE
#undef QREL
}
#undef KSWZ
#undef SBAR
}

__device__ __forceinline__ void top3_insert(float g, int idx, float& v1, float& v2, float& v3, int& i1, int& i2, int& i3) {
    if (g > v1) { v3 = v2; i3 = i2; v2 = v1; i2 = i1; v1 = g; i1 = idx; } else if (g > v2) { v3 = v2; i3 = i2; v2 = g; i2 = idx; } else if (g > v3) { v3 = g; i3 = idx; }
}
__device__ __forceinline__ bool gate_before(float va, int ia, float vb, int ib) { return va > vb || (va == vb && ia < ib); }
#define GSWZ(row, colB) ((row) * 256 + ((colB) ^ (((row) & 7) << 4)))
__device__ __forceinline__ void gate_set(const bf16* __restrict__ proj, int b, int h, int qrow, int own, const char* khi, const char* klo, int r32, int hi,
                                         float& v1, float& v2, float& v3, int& i1, int& i2, int& i3) {
    att::bf16x8 q[8]; att::ld_q(proj, b, h, qrow, hi, q);
    att::f32x16 g = {};
#pragma unroll
    for (int d0 = 0; d0 < 8; ++d0) { const int cb = (d0 * 16 + hi * 8) * 2;
        const att::bf16x8 ah = *reinterpret_cast<const att::bf16x8*>(khi + GSWZ(r32, cb)), al = *reinterpret_cast<const att::bf16x8*>(klo + GSWZ(r32, cb));
        g = __builtin_amdgcn_mfma_f32_32x32x16_bf16(ah, q[d0], g, 0, 0, 0); g = __builtin_amdgcn_mfma_f32_32x32x16_bf16(al, q[d0], g, 0, 0, 0); }
    float w1 = -INFINITY, w2 = -INFINITY, w3 = -INFINITY; int j1 = 0, j2 = 0, j3 = 0;
#pragma unroll
    for (int r = 0; r < 16; ++r) { const int idx = (r & 3) + 8 * (r >> 2) + 4 * hi; const float gv = (idx < own) ? g[r] : -INFINITY;
        const bool b1 = gv > w1, b2 = gv > w2, b3 = gv > w3;
        const float n3 = b2 ? w2 : (b3 ? gv : w3); const int m3 = b2 ? j2 : (b3 ? idx : j3);
        const float n2 = b1 ? w1 : (b2 ? gv : w2); const int m2 = b1 ? j1 : (b2 ? idx : j2);
        const float n1 = b1 ? gv : w1;             const int m1 = b1 ? idx : j1;
        w1 = n1; w2 = n2; w3 = n3; j1 = m1; j2 = m2; j3 = m3; }
    v1 = w1; v2 = w2; v3 = w3; i1 = j1; i2 = j2; i3 = j3;
}
__device__ __forceinline__ void attn_gate_lists(Frame& F, const bool dummy = false) {
    const bf16* proj = WSP(bf16, WS_PROJ); const float* kmean = WSP(float, WS_KMEAN); unsigned* alist = dummy ? WSP(unsigned, WS_Z) : WSP(unsigned, WS_ALIST);
    const int cw_acnt = dummy ? 65536 : CW_ACNT;
    char* khi = (char*)F.ldsg; char* klo = khi + 8192;
    LAS unsigned* ghist = (LAS unsigned*)(F.lds + ATAB_OFF);
    const int lane = F.lane, r32 = lane & 31, hi = lane >> 5;
    for (int it = F.vcu; it < BATCH * NH * (SEQ / 512); it += F.G) {
        const int i2 = it & 15, h = (it >> 4) & 7, b = it >> 7;
        __syncthreads();
        { const int row = F.tid >> 4, c8 = (F.tid & 15) * 8; const GAS f32x4* src = (const GAS f32x4*)(kmean + ((size_t)(b * NH + h) * NBLK + row) * HD + c8); const f32x4 x0 = src[0], x1 = src[1];
          v4u hw, lw; hw.x = pk2(x0.x, x0.y); hw.y = pk2(x0.z, x0.w); hw.z = pk2(x1.x, x1.y); hw.w = pk2(x1.z, x1.w);
          lw.x = pk2(x0.x - bflo(hw.x), x0.y - bfhi(hw.x)); lw.y = pk2(x0.z - bflo(hw.y), x0.w - bfhi(hw.y)); lw.z = pk2(x1.x - bflo(hw.z), x1.y - bfhi(hw.z)); lw.w = pk2(x1.z - bflo(hw.w), x1.w - bfhi(hw.w));
          *(v4u*)(khi + GSWZ(row, c8 * 2)) = hw; *(v4u*)(klo + GSWZ(row, c8 * 2)) = lw; if (F.tid < 32) ghist[F.tid] = 0u; }
        __syncthreads();
        const int qbase = i2 * 512 + F.wave * 64, own = qbase >> 8;
        const int qpos = qbase + lane;
        int s0 = -1, s1i = -1, s2i = -1, off0 = 0, off1 = 0, off2 = 0; unsigned wb = 0;
        if (own > 0) {
            float a1, a2, a3, c1, c2, c3; int ia1, ia2, ia3, ic1, ic2, ic3;
            gate_set(proj, b, h, qbase + r32, own, khi, klo, r32, hi, a1, a2, a3, ia1, ia2, ia3);
            gate_set(proj, b, h, qbase + 32 + r32, own, khi, klo, r32, hi, c1, c2, c3, ic1, ic2, ic3);
            float v1 = hi ? c1 : a1, v2 = hi ? c2 : a2, v3 = hi ? c3 : a3; int i1 = hi ? ic1 : ia1, i2s = hi ? ic2 : ia2, i3 = hi ? ic3 : ia3;
            { const float s1 = hi ? a1 : c1, s2 = hi ? a2 : c2, s3 = hi ? a3 : c3; const int t1 = hi ? ia1 : ic1, t2 = hi ? ia2 : ic2, t3 = hi ? ia3 : ic3;
              const float p1 = __shfl_xor(s1, 32), p2 = __shfl_xor(s2, 32), p3 = __shfl_xor(s3, 32); const int u1 = __shfl_xor(t1, 32), u2 = __shfl_xor(t2, 32), u3 = __shfl_xor(t3, 32);
#define GINS(pv, pi) do { if (gate_before(pv, pi, v1, i1)) { v3 = v2; i3 = i2s; v2 = v1; i2s = i1; v1 = pv; i1 = pi; } else if (gate_before(pv, pi, v2, i2s)) { v3 = v2; i3 = i2s; v2 = pv; i2s = pi; } \
                  else if (gate_before(pv, pi, v3, i3)) { v3 = pv; i3 = pi; } } while (0)
              GINS(p1, u1); GINS(p2, u2); GINS(p3, u3);
#undef GINS
            }
            (void)v1; (void)v2; (void)v3;
            const int nv = own < 3 ? own : 3;
            s0 = i1; s1i = nv > 1 ? i2s : -1; s2i = nv > 2 ? i3 : -1;
            int mycnt = 0;
            const unsigned long long lt = (1ull << lane) - 1ull;
            for (int j = 0; j < own; ++j) {
                const bool mine = (s0 == j) || (s1i == j) || (s2i == j);
                const unsigned long long bal = __ballot(mine);
                const int cw = __popcll(bal), of = __popcll(bal & lt);
                if (lane == j) mycnt = cw;
                if (s0 == j) off0 = of; if (s1i == j) off1 = of; if (s2i == j) off2 = of;
            }
            if (lane < own && mycnt > 0) wb = __hip_atomic_fetch_add(ghist + lane, (unsigned)mycnt, __ATOMIC_RELAXED, __HIP_MEMORY_SCOPE_WORKGROUP);
        }
        __syncthreads();
        if (F.tid < 32) { const unsigned c = ghist[F.tid]; ghist[32 + F.tid] = c ? atomicAdd((unsigned*)(F.ctl + cw_acnt + 16 * ((b * NH + h) * NBLK + F.tid)), c) : 0u; }
        __syncthreads();
        if (own > 0) {
            const unsigned base = ghist[32 + (lane & 31)] + wb;
            const unsigned b0 = (unsigned)__shfl((int)base, s0 < 0 ? 0 : s0), b1 = (unsigned)__shfl((int)base, s1i < 0 ? 0 : s1i), b2 = (unsigned)__shfl((int)base, s2i < 0 ? 0 : s2i);
            unsigned* lb = alist + (size_t)(b * NH + h) * LISTCAP;
            lb[list_base(s0) + b0 + off0] = (unsigned)qpos;
            if (s1i >= 0) lb[list_base(s1i) + b1 + off1] = (unsigned)qpos | (1u << 13);
            if (s2i >= 0) lb[list_base(s2i) + b2 + off2] = (unsigned)qpos | (2u << 13);
        }
    }
#undef GSWZ
}
constexpr int KVCOST = 8;
constexpr int OWNG = 8;
__device__ __forceinline__ void attn_all(Frame& F) {
    const bf16* proj = WSP(bf16, WS_PROJ); const unsigned* alist = WSP(unsigned, WS_ALIST);
    LAS int* pre = (LAS int*)(F.lds + ATAB_OFF);
    __syncthreads();
    { const int t = F.tid; const int n0 = (int)((__hip_atomic_load(F.ctl + CW_ACNT + 16 * (2 * t), RLX_AGENT) + 31u) >> 5), n1 = (int)((__hip_atomic_load(F.ctl + CW_ACNT + 16 * (2 * t + 1), RLX_AGENT) + 31u) >> 5);
      const int c0 = n0 + OWNG + KVCOST, c1 = n1 + OWNG + KVCOST;
      const int s = c0 + c1; int x = s;
#pragma unroll
      for (int o = 1; o < 64; o <<= 1) { const int y = __shfl_up(x, o); if (F.lane >= o) x += y; }
      if (F.lane == 63) pre[1032 + F.wave] = x;
      __syncthreads();
      int woff = 0;
#pragma unroll
      for (int w = 0; w < 8; ++w) woff += (w < F.wave) ? pre[1032 + w] : 0;
      const int excl = woff + x - s;
      pre[2 * t] = excl; pre[2 * t + 1] = excl + c0; if (t == 511) pre[1024] = excl + s; }
    __syncthreads();
    const int CT = pre[1024];
    const int c_lo = (int)(((long)CT * F.vcu) / F.G), c_hi = (int)(((long)CT * (F.vcu + 1)) / F.G);
    int lo = 0, hi = 1023;
    while (lo < hi) { const int mid = (lo + hi + 1) >> 1; if (pre[mid] <= c_lo) lo = mid; else hi = mid - 1; }
    for (int item = lo; item < 1024 && pre[item] < c_hi; ++item) {
        const int ngi = pre[item + 1] - pre[item] - KVCOST;
        int g_lo = c_lo - pre[item] - KVCOST, g_hi = c_hi - pre[item] - KVCOST;
        g_lo = g_lo < 0 ? 0 : g_lo; g_hi = g_hi > ngi ? ngi : g_hi;
        if (g_lo >= g_hi) continue;
        const int j = item & 31, bh = item >> 5, h = bh & 7, b = bh >> 3, nsel = ngi - OWNG;
        const int cnt = (int)__hip_atomic_load(F.ctl + CW_ACNT + 16 * item, RLX_AGENT);
        att::kv_load_block(proj, b, h, j, (char*)F.ldsg);
        const unsigned* lst = alist + (size_t)bh * LISTCAP + list_base(j);
        { const int r32 = F.lane & 31, hi2 = F.lane >> 5;
          for (int gi = g_lo + F.wave; gi < g_hi; gi += NWAVES) {
              if (gi < nsel) {
                  const bool valid = gi * 32 + r32 < cnt; const unsigned e = lst[gi * 32 + (valid ? r32 : 0)]; att::bf16x8 q[8];
                  att::ld_q(proj, b, h, (int)(e & 8191u), hi2, q);
                  att::wave_group<false, 4>(b, h, j, gi, (int)(e & 8191u), (int)(e >> 13), valid, q, (bf16*)F.out, WSP(float, WS_ML), (char*)F.ldsg);
              } else {
                  const int g = gi - nsel, qpos = j * MBLK + g * 32 + r32; att::bf16x8 q[8]; att::ld_q(proj, b, h, qpos, hi2, q);
                  switch (g >> 1) {
                    case 0: att::wave_group<true, 1>(b, h, j, g, qpos, 3, true, q, (bf16*)F.out, WSP(float, WS_ML), (char*)F.ldsg); break;
                    case 1: att::wave_group<true, 2>(b, h, j, g, qpos, 3, true, q, (bf16*)F.out, WSP(float, WS_ML), (char*)F.ldsg); break;
                    case 2: att::wave_group<true, 3>(b, h, j, g, qpos, 3, true, q, (bf16*)F.out, WSP(float, WS_ML), (char*)F.ldsg); break;
                    default: att::wave_group<true, 4>(b, h, j, g, qpos, 3, true, q, (bf16*)F.out, WSP(float, WS_ML), (char*)F.ldsg); break; }
              }
          } }
    }
    __syncthreads();
}

#ifndef STAG16
#define STAG16 0
#endif
#ifndef STAG7
#define STAG7 0
#endif
#ifndef P1_NC
#define P1_NC 128
#define P1_K1 6
#endif
#ifndef MK_N_LAUNCHES
#define MK_N_LAUNCHES 1
#endif
constexpr int NPHASES = 18;
#ifndef PROBE_DUP
#define PROBE_DUP (-1)
#endif

constexpr int N_LAUNCHES = MK_N_LAUNCHES;
struct Args { const float* in[21]; float* out; unsigned char* ws; int ph_lo, ph_hi; };
__global__ void __launch_bounds__(NWAVES * 64, 2) hymba_fwd(Args args) {
    extern __shared__ __attribute__((aligned(16))) unsigned char lds[];
    Frame F;
    F.lds = (LAS unsigned char*)lds; F.ldsg = lds;
    F.MISC = (volatile LAS unsigned*)(F.lds + MISC_OFF);
    F.tid = threadIdx.x; F.lane = F.tid & 63; F.wave = __builtin_amdgcn_readfirstlane(F.tid >> 6);
    F.G = gridDim.x; { const int bx = blockIdx.x; F.vcu = (F.G % 8 == 0) ? (bx % 8) * (F.G / 8) + bx / 8 : bx; }
    F.ws = args.ws; F.ctl = (gu32*)(args.ws + WS_CTL); F.out = args.out;
    F.x = args.in[0]; F.p = args.in[1]; F.g_mix = args.in[2]; F.w_in = args.in[3]; F.beta_attn = args.in[4]; F.w_pool = args.in[5]; F.pool_scale = args.in[6]; F.w_out = args.in[7];
    F.g_ffn = args.in[8]; F.w_rg = args.in[9]; F.b_rg = args.in[10]; F.w_re = args.in[11]; F.b_re = args.in[12]; F.w_eg = args.in[13]; F.w_eu = args.in[14]; F.w_ed = args.in[15];
    F.g_ple = args.in[16]; F.w_ple = args.in[17]; F.w_pg = args.in[18]; F.b_pg = args.in[19]; F.g_final = args.in[20];
    for (int u = F.tid; u < 64; u += NWAVES * 64) ((LAS unsigned*)(F.lds + LDSCTL_OFF))[u] = 0u;
    __syncthreads();
    XcdBarrier bar; bar.bar = (unsigned*)(F.ctl + CW_BAR); bar.x = 0; bar.st = nullptr;
    if (N_LAUNCHES == 1) bar = xcd_barrier_post((unsigned*)(F.ctl + CW_BAR), F.MISC + 8);
#define GRID_BAR() do { if (N_LAUNCHES == 1) xcd_barrier(bar); } while (0)
#define STAGGER(n) do { if (N_LAUNCHES == 1 && (n) > 0) { const int g_ = (cid >> 3) & 3; for (int k_ = 0; k_ < g_ * (n); ++k_) __builtin_amdgcn_s_sleep(127); } } while (0)
    const int lo = args.ph_lo, hi = args.ph_hi;
#define IN(k) (lo <= (k) && (k) < hi)
#define BOTH(k) (IN(k) && IN((k) + 1))
    const int cid = (int)blockIdx.x;

    if (IN(0)) { p0_prologue(F); if (PROBE_DUP == 0) { GRID_BAR(); p0_prologue(F); } if (BOTH(0)) GRID_BAR(); }

    if (IN(1)) {
#define PHASE_GEMM_1 \
        EpiBf16 E{WSP(bf16, WS_PROJ), NIN, 0, WSP(float, WS_RS0)}; \
        { DenseSched S; S.ord.init(T / 256, NIN / 256, F.G, cid); S.A = (const char*)WSP(bf16, WS_XN); S.Bt = (const char*)WSP(bf16, WS_WIN); S.a_tile = (size_t)256 * DM * 2; S.b_tile = (size_t)256 * DM * 2; S.a_pn_off = 0; \
          if (split_) S.ord.lim = K1_ * F.G;                         \
          pg8::gemm_phase<EpiBf16, DenseSched, false>(F.lds + RING_OFF, DM * 2, DM, S, E); } \
        if (split_) { DenseSched S; S.ord.init(T / 256, NIN / 256, F.G - NC_, cid - NC_); S.A = (const char*)WSP(bf16, WS_XN); S.Bt = (const char*)WSP(bf16, WS_WIN); S.a_tile = (size_t)256 * DM * 2; S.b_tile = (size_t)256 * DM * 2; S.a_pn_off = 0; \
          S.ord.L0 = K1_ * F.G;                                      \
          pg8::gemm_phase<EpiBf16, DenseSched, false>(F.lds + RING_OFF, DM * 2, DM, S, E); } \

#define PHASE_BODY_1 \
        constexpr int NC_ = P1_NC, K1_ = P1_K1; \
        const bool split_ = (F.G == 256); const int npart_ = split_ ? NC_ : F.G; \
        if (cid < npart_) conv_experts(F, cid, npart_); \
        __syncthreads(); \
        PHASE_GEMM_1 \

        { PHASE_BODY_1 }
        if (PROBE_DUP == 1) { GRID_BAR(); { PHASE_BODY_1 } }
        if (PROBE_DUP == 101) { GRID_BAR(); { constexpr int NC_ = 128, K1_ = 6; const bool split_ = (F.G == 256); PHASE_GEMM_1 } }
        if (PROBE_DUP == 102) { GRID_BAR(); { constexpr int NC_ = 128; const bool split_ = (F.G == 256); const int npart_ = split_ ? NC_ : F.G; if (cid < npart_) conv_experts(F, cid, npart_); __syncthreads(); } }
        if (BOTH(1)) GRID_BAR();
    }
    if (IN(2)) { p2_kmean_z(F); if (PROBE_DUP == 2) { GRID_BAR(); p2_kmean_z(F); } if (BOTH(2)) GRID_BAR(); }
    if (IN(3)) {
#define PHASE_BODY_3 \
        DenseSched S; S.ord.init(T / 256, NPG, F.G, cid); S.A = (const char*)WSP(bf16, WS_Z); S.Bt = (const char*)WSP(bf16, WS_WPOOL); S.a_tile = (size_t)256 * PW * 2; S.b_tile = (size_t)PG * PG * 2; S.a_pn_off = PG * 2; \
        EpiBf16 E{WSP(bf16, WS_MIX), DM, AW, WSP(float, WS_RS0) + 65536}; \
        pg8::gemm_phase<EpiBf16, DenseSched, false>(F.lds + RING_OFF, PW * 2, PG, S, E); \
        __syncthreads(); \
        attn_gate_lists(F); \

        { PHASE_BODY_3 }
        if (PROBE_DUP == 103) { GRID_BAR(); attn_gate_lists(F, true); }
        if (PROBE_DUP == 104) { GRID_BAR(); { DenseSched S; S.ord.init(T / 256, NPG, F.G, cid); S.A = (const char*)WSP(bf16, WS_Z); S.Bt = (const char*)WSP(bf16, WS_WPOOL); S.a_tile = (size_t)256 * PW * 2; S.b_tile = (size_t)PG * PG * 2; S.a_pn_off = PG * 2; EpiBf16 E{WSP(bf16, WS_MIX), DM, AW, WSP(float, WS_RS0) + 65536}; pg8::gemm_phase<EpiBf16, DenseSched, false>(F.lds + RING_OFF, PW * 2, PG, S, E); } }
        if (BOTH(3)) GRID_BAR();
    }
    if (IN(4)) { attn_all(F); if (PROBE_DUP == 4) { GRID_BAR(); attn_all(F); } if (BOTH(4)) GRID_BAR(); }
    if (IN(6)) { p4_mix_norm(F); if (PROBE_DUP == 6) { GRID_BAR(); p4_mix_norm(F); } if (BOTH(6)) GRID_BAR(); }
    if (IN(7)) {
#define PHASE_BODY_7 \
        DenseSched S; S.ord.init(T / 256, DM / 256, F.G, cid); S.A = (const char*)WSP(bf16, WS_MIX); S.Bt = (const char*)WSP(bf16, WS_WOUT); S.a_tile = (size_t)256 * DM * 2; S.b_tile = (size_t)256 * DM * 2; S.a_pn_off = 0; \
        EpiResBf16 E{WSP(bf16, WS_XN), (bf16*)F.out, DM, WSP(float, WS_SSQ)}; \
        pg8::gemm_phase<EpiResBf16, DenseSched, false>(F.lds + RING_OFF, DM * 2, DM, S, E); \

        STAGGER(STAG7);
        { PHASE_BODY_7 }
        if (PROBE_DUP == 7) { GRID_BAR(); { PHASE_BODY_7 } }
        if (BOTH(7)) GRID_BAR();
    }
    if (IN(9)) {
#define PHASE_BODY_9 \
        DenseSched S; S.ord.init(T / 256, 2, F.G, cid); S.A = (const char*)F.out  ; S.Bt = (const char*)WSP(bf16, WS_WR); S.a_tile = (size_t)256 * DM * 2; S.b_tile = (size_t)(DM / 2) * 2; S.a_pn_off = (size_t)(DM / 2) * 2; \
        EpiLogit E{WSP(float, WS_LOGIT)}; \
        pg8::gemm_phase<EpiLogit, DenseSched, false, GEMM_ALIGN, GEMM_SP2, true>(F.lds + RING_OFF, DM * 2, DM / 2, S, E, DM);        \

        { PHASE_BODY_9 }
        if (PROBE_DUP == 9) { GRID_BAR(); { PHASE_BODY_9 } }
        if (BOTH(9)) GRID_BAR();
    }
    if (IN(10)) { p8_route(F); if (BOTH(10)) GRID_BAR(); }
    if (IN(12)) {
#define PHASE_BODY_12 \
        const int TT = build_tile_table(F); \
        MoeSched S; S.TT = TT; S.NCT = 4; S.G = F.G; S.c = cid; S.tile_e = (const LAS int*)(F.lds + TAB_OFF); S.A = (const char*)F.out  ; S.Bt = (const char*)WSP(bf16, WS_WGU); \
        S.b_exp = (size_t)1024 * DM * 2; S.b_ct = (size_t)256 * DM * 2; S.a_tile = 0; S.elist = (const int*)(F.ws + WS_ROUTE + RT_ELIST); S.a_row = DM * 2; \
        EpiGU E{WSP(bf16, WS_MIX), WSP(float, WS_ERS)}; \
        pg8::gemm_phase<EpiGU, MoeSched, true>(F.lds + RING_OFF, 0u, DM, S, E); \

        { PHASE_BODY_12 }
        if (PROBE_DUP == 12) { GRID_BAR(); { PHASE_BODY_12 } }
        if (BOTH(12)) GRID_BAR();
    }
    if (IN(13)) {
#define PHASE_BODY_13 \
        const int TT = (N_LAUNCHES == 1) ? ((const LAS int*)(F.lds + TAB_OFF))[MAXTILES + 64] : build_tile_table(F);        \
        MoeSched S; S.TT = TT; S.NCT = 8; S.G = F.G; S.c = cid; S.tile_e = (const LAS int*)(F.lds + TAB_OFF); S.A = (const char*)WSP(bf16, WS_MIX); S.Bt = (const char*)WSP(bf16, WS_WD); \
        S.b_exp = (size_t)DM * DE * 2; S.b_ct = (size_t)256 * DE * 2; S.a_tile = (size_t)256 * DE * 2; S.elist = (const int*)(F.ws + WS_ROUTE + RT_ELIST); S.a_row = 0; \
        EpiDown E{WSP(bf16, WS_PROJ), (const int*)(F.ws + WS_ROUTE + RT_ELIST), (const float*)(F.ws + WS_ROUTE + RT_EWL), WSP(bf16, WS_Z)};        \
        pg8::gemm_phase<EpiDown, MoeSched, false>(F.lds + RING_OFF, DE * 2, DE, S, E); \

        { PHASE_BODY_13 }
        if (PROBE_DUP == 13) { GRID_BAR(); { PHASE_BODY_13 } }
        if (BOTH(13)) GRID_BAR();
    }
    if (IN(14)) { p12_combine(F); __syncthreads(); }
    if (IN(15)) {
#define PHASE_BODY_15 \
        DenseSched S; S.ord.init(T / 256, DM / 256, F.G, cid); S.A = (const char*)WSP(bf16, WS_PBF); S.Bt = (const char*)WSP(bf16, WS_WPLE); S.a_tile = (size_t)256 * PLE * 2; S.b_tile = (size_t)256 * PLE * 2; S.a_pn_off = 0; \
        EpiBf16 E{WSP(bf16, WS_MIX), DM, 0, WSP(float, WS_RS0) + 65536}; \
        pg8::gemm_phase<EpiBf16, DenseSched, false>(F.lds + RING_OFF, PLE * 2, PLE, S, E); \

        { PHASE_BODY_15 }
        if (PROBE_DUP == 15) { GRID_BAR(); { PHASE_BODY_15 } }
        if (BOTH(15)) GRID_BAR();
    }
    if (IN(16)) {
        STAGGER(STAG16);
#define PHASE_BODY_16 \
        DenseSched S; S.ord.init(T / 256, DM / 256, F.G, cid); S.A = (const char*)F.out  ; S.Bt = (const char*)WSP(bf16, WS_WPG); S.a_tile = (size_t)256 * DM * 2; S.b_tile = (size_t)256 * DM * 2; S.a_pn_off = 0; \
        EpiPle E{(const bf16*)F.out, WSP(bf16, WS_PROJ), WSP(bf16, WS_MIX), F.b_pg, WSP(float, WS_RS3)}; \
        pg8::gemm_phase<EpiPle, DenseSched, false>(F.lds + RING_OFF, DM * 2, DM, S, E); \

        { PHASE_BODY_16 }
        if (PROBE_DUP == 16) { GRID_BAR(); { PHASE_BODY_16 } }
        if (BOTH(16)) GRID_BAR();
    }
    if (IN(17)) { p15_final(F); if (PROBE_DUP == 17) { GRID_BAR(); p15_final(F); } }
#undef IN
#undef BOTH
}

extern "C" void kernel_launch(void* const* d_in, const int* in_sizes, int n_in, void* d_out, int out_size, void* d_ws, size_t ws_size, hipStream_t stream) {
    static int grid = 0;
    if (grid == 0) {
        if (n_in != 21 || in_sizes[0] != T * DM || out_size != T * DM || ws_size < WS_END2) { fprintf(stderr, "kernel_launch: shape mismatch n_in %d in0 %d out %d ws %zu (need %zu)\n", n_in, n_in > 0 ? in_sizes[0] : -1, out_size, ws_size, (size_t)WS_END2); grid = -1; return; }
        int dev = 0, cus = 0, per_cu = 0;
        if (hipGetDevice(&dev) != hipSuccess || hipDeviceGetAttribute(&cus, hipDeviceAttributeMultiprocessorCount, dev) != hipSuccess) { grid = -1; return; }
        if (hipFuncSetAttribute((const void*)hymba_fwd, hipFuncAttributeMaxDynamicSharedMemorySize, LDS_BYTES) != hipSuccess) { fprintf(stderr, "kernel_launch: hipFuncSetAttribute failed\n"); grid = -1; return; }
        if (hipOccupancyMaxActiveBlocksPerMultiprocessor(&per_cu, (const void*)hymba_fwd, NWAVES * 64, LDS_BYTES) != hipSuccess || per_cu < 1) { fprintf(stderr, "kernel_launch: occupancy query says %d\n", per_cu); }
        (void)hipGetLastError();
        grid = cus;
    }
    if (grid < 0) return;
    (void)hipMemsetAsync((char*)d_ws + WS_CTL, 0, CTL_ZERO_BYTES, stream);
    Args a{};
    for (int i = 0; i < 21; ++i) a.in[i] = (const float*)d_in[i];
    a.out = (float*)d_out; a.ws = (unsigned char*)d_ws;
    if (N_LAUNCHES == 1) { a.ph_lo = 0; a.ph_hi = NPHASES; hipLaunchKernelGGL(hymba_fwd, dim3(grid), dim3(NWAVES * 64), LDS_BYTES, stream, a); }
    else { for (int li = 0; li < NPHASES; ++li) { a.ph_lo = li; a.ph_hi = li + 1; hipLaunchKernelGGL(hymba_fwd, dim3(grid), dim3(NWAVES * 64), LDS_BYTES, stream, a); } }
    const hipError_t le = hipPeekAtLastError();
    if (le != hipSuccess) fprintf(stderr, "kernel_launch: launch failed: %s\n", hipGetErrorName(le));
}
```

```cpp
#include <hip/hip_runtime.h>
#include <cstdio>
#include <cstdint>

namespace pg8 {
#define PG8_LAS __attribute__((address_space(3)))
typedef unsigned short bf16_t;
typedef short bf16x8 __attribute__((ext_vector_type(8)));
typedef float f32x4 __attribute__((ext_vector_type(4)));
typedef unsigned u32x4 __attribute__((ext_vector_type(4)));
typedef unsigned u32x2 __attribute__((ext_vector_type(2)));
constexpr int BM = 256, BK = 64, HALF = 128, HTB = HALF * BK * 2  , STAGE_BYTES = 8 * HTB, NXCD = 8, WGM = 8;

__host__ __device__ __forceinline__ int lds_byte(int r, int c) { const int st = (r >> 4) * 2 + (c >> 5), rr = r & 15, cc = c & 31, ob = rr * 64 + cc * 2; return st * 1024 + (ob ^ (((ob >> 9) & 1) << 5)); }
__host__ __device__ __forceinline__ void stage_rc(int b, int& R, int& C) { const int st = b / 1024, sb = b % 1024, swz = sb ^ (((sb >> 9) & 1) << 5); R = (st >> 1) * 16 + swz / 64; C = (st & 1) * 32 + (swz % 64) / 2; }
__host__ __device__ __forceinline__ int perm32(int rho) { const int n = rho >> 4, i = rho & 15; return 8 * (i >> 2) + 4 * n + (i & 3); }

struct Unit { const char* a; const char* b; int pm, pn, x0, x1; };

struct TileOrder {
    int nM, nN, nwg, G, c, L0, lim;
    __device__ __forceinline__ void init(int nM_, int nN_, int G_, int c_) { nM = nM_; nN = nN_; nwg = nM * nN; G = G_; c = c_; L0 = 0; lim = nwg; }
    __device__ __forceinline__ bool tile(int i, int& pm, int& pn) const { return map((long)L0 + (long)i * G + c, pm, pn); }
    __device__ __forceinline__ bool map(long L, int& pm, int& pn) const {
        if (c < 0 || L >= lim) return false;
        int wgid = (int)L; { const int q = nwg / NXCD, r = nwg % NXCD, xcd = wgid % NXCD, off = wgid / NXCD; wgid = (xcd < r ? xcd * (q + 1) : r * (q + 1) + (xcd - r) * q) + off; }
        const int nig = WGM * nN, gid = wgid / nig, fm = gid * WGM, gsz = (nM - fm) < WGM ? (nM - fm) : WGM;
        pm = fm + ((wgid % nig) % gsz); pn = (wgid % nig) / gsz; return true;
    }
};

__device__ __forceinline__ unsigned cvt_pk_bf16(float lo, float hi) { unsigned r; asm volatile("v_cvt_pk_bf16_f32 %0, %1, %2" : "=v"(r) : "v"(lo), "v"(hi)); return r; }

#ifndef GEMM_ALIGN
#define GEMM_ALIGN true
#endif
#ifndef GEMM_SP2
#define GEMM_SP2 true
#endif
#ifndef EPI_RELAX
#define EPI_RELAX 1
#endif
template <class Epi, class Sched, bool GATHER, bool ALIGN_EPI = GEMM_ALIGN, bool SP2 = GEMM_SP2, bool HALFN = false>
__device__ __forceinline__ void gemm_phase(PG8_LAS unsigned char* lds, const unsigned lda, const int K, const Sched& S, const Epi& E, const int ldb_ = 0) {
    const int tid = threadIdx.x, wid = __builtin_amdgcn_readfirstlane(tid >> 6), lane = tid & 63, wr = wid >> 2, wc = wid & 3, fr = lane & 15, fq = lane >> 4;
    const int nt = K / BK, ldb = ldb_ ? ldb_ : K;
    unsigned voffB[2]; int RA[2], CA[2];
#pragma unroll
    for (int i = 0; i < 2; ++i) { int R, C; stage_rc(tid * 16 + i * 8192, R, C); const int Rb = Epi::PERM ? ((R & ~31) + perm32(R & 31)) : R;
        RA[i] = R; CA[i] = C; voffB[i] = (unsigned)(Rb * ldb + C) * 2u; }
    const size_t kstep = (size_t)(BK * 2);
    const size_t hstepB = (size_t)HALF * ldb * 2;
    const unsigned ldsw = (unsigned)wid * 1024u;
    const int aoff = lds_byte(wr * 64 + fr, fq * 8), boff = lds_byte(wc * 32 + fr, fq * 8);
#define PG8_SA(b, h) (((b) * 2 + (h)) * HTB)
#define PG8_SB(b, h) ((4 + (b) * 2 + (h)) * HTB)
#define PG8_STAGE(bufoff, gbase, voff) do { _Pragma("unroll") for (int _i = 0; _i < 2; ++_i) \
        __builtin_amdgcn_global_load_lds((const unsigned*)((const char*)(gbase) + (voff)[_i]), (PG8_LAS unsigned*)(lds + (bufoff) + ldsw + _i * 8192), 16, 0, 0); } while (0)
#define PG8_STAGE2(bufoff, gbase, v0, v1) do { \
        __builtin_amdgcn_global_load_lds((const unsigned*)((const char*)(gbase) + (v0)), (PG8_LAS unsigned*)(lds + (bufoff) + ldsw), 16, 0, 0); \
        __builtin_amdgcn_global_load_lds((const unsigned*)((const char*)(gbase) + (v1)), (PG8_LAS unsigned*)(lds + (bufoff) + ldsw + 8192), 16, 0, 0); } while (0)
#define PG8_LDA(dst, b, h) do { _Pragma("unroll") for (int m = 0; m < 4; ++m) _Pragma("unroll") for (int k = 0; k < 2; ++k) dst[m][k] = *(const PG8_LAS bf16x8*)(lds + PG8_SA(b, h) + aoff + m * 2048 + k * 1024); } while (0)
#define PG8_LDB(dst, b, h) do { _Pragma("unroll") for (int n = 0; n < 2; ++n) _Pragma("unroll") for (int k = 0; k < 2; ++k) dst[n][k] = *(const PG8_LAS bf16x8*)(lds + PG8_SB(b, h) + boff + n * 2048 + k * 1024); } while (0)
#define PG8_MMA(ai, bj, At, Bt) do { __builtin_amdgcn_s_setprio(1); _Pragma("unroll") for (int m = 0; m < 4; ++m) _Pragma("unroll") for (int n = 0; n < 2; ++n) _Pragma("unroll") for (int k = 0; k < 2; ++k) \
        acc[ai][bj][m][n] = __builtin_amdgcn_mfma_f32_16x16x32_bf16(Bt[n][k], At[m][k], acc[ai][bj][m][n], 0, 0, 0); __builtin_amdgcn_s_setprio(0); } while (0)
#define PG8_WAIT_V(n) asm volatile("s_waitcnt vmcnt(" #n ")" ::: "memory")
#define PG8_WAIT_L(n) asm volatile("s_waitcnt lgkmcnt(" #n ")" ::: "memory")
#define PG8_WAIT_V8_OR_24(r) asm volatile("s_cmp_lg_u32 %0, 0\n\ts_cbranch_scc1 1f\n\ts_waitcnt vmcnt(8)\n1:\n\ts_waitcnt vmcnt(24)" :: "s"(r) : "memory", "scc")
#define PG8_BAR __builtin_amdgcn_s_barrier()
#define PG8_SCHED __builtin_amdgcn_sched_barrier(0)
    Unit cur, nxt; int ui = 0;
    if (!S.next(0, cur)) return;
    unsigned c00, c01, c10, c11, n00 = 0, n01 = 0, n10 = 0, n11 = 0;
    if constexpr (GATHER) {
        c00 = S.row_off(cur, RA[0]) + CA[0] * 2u; c01 = S.row_off(cur, RA[1]) + CA[1] * 2u; c10 = S.row_off(cur, HALF + RA[0]) + CA[0] * 2u; c11 = S.row_off(cur, HALF + RA[1]) + CA[1] * 2u;
    } else {
        c00 = (unsigned)RA[0] * lda + CA[0] * 2u; c01 = (unsigned)RA[1] * lda + CA[1] * 2u; c10 = c00 + HALF * lda; c11 = c01 + HALF * lda;
    }
    f32x4 acc[2][2][4][2];
#pragma unroll
    for (int a = 0; a < 2; ++a)
#pragma unroll
        for (int b = 0; b < 2; ++b)
#pragma unroll
            for (int m = 0; m < 4; ++m)
#pragma unroll
                for (int n = 0; n < 2; ++n) acc[a][b][m][n] = (f32x4){0.f, 0.f, 0.f, 0.f};
    bf16x8 At[4][2], B0[2][2], B1[2][2];
    const char* cA = cur.a; const char* cB = cur.b;
    if constexpr (SP2) {
        PG8_STAGE(PG8_SB(0, 0), cB, voffB); PG8_STAGE(PG8_SB(0, 1), cB + hstepB, voffB); PG8_STAGE2(PG8_SA(0, 0), cA, c00, c01); PG8_STAGE2(PG8_SA(0, 1), cA, c10, c11);
        if (wr == 1) PG8_BAR;
        PG8_WAIT_V(2); PG8_BAR;
        PG8_STAGE(PG8_SB(1, 0), cB + kstep, voffB); PG8_STAGE2(PG8_SA(1, 0), cA + kstep, c00, c01); PG8_STAGE(PG8_SB(1, 1), cB + hstepB + kstep, voffB);
        PG8_WAIT_V(6); PG8_BAR;
    } else {
        PG8_STAGE(PG8_SB(0, 0), cB, voffB); PG8_STAGE2(PG8_SA(0, 0), cA, c00, c01); PG8_STAGE(PG8_SB(0, 1), cB + hstepB, voffB); PG8_STAGE2(PG8_SA(0, 1), cA, c10, c11);
        if (wr == 1) PG8_BAR;
        PG8_WAIT_V(4); PG8_BAR;
        PG8_STAGE(PG8_SB(1, 0), cB + kstep, voffB); PG8_STAGE2(PG8_SA(1, 0), cA + kstep, c00, c01); PG8_STAGE(PG8_SB(1, 1), cB + hstepB + kstep, voffB);
        PG8_WAIT_V(6); PG8_BAR;
    }
    for (;;) {
        const bool has_next = S.next(ui + 1, nxt);
        const char* nA = has_next ? nxt.a : cA; const char* nB = has_next ? nxt.b : cB;
        if constexpr (GATHER) {
            if (has_next) { n00 = S.row_off(nxt, RA[0]) + CA[0] * 2u; n01 = S.row_off(nxt, RA[1]) + CA[1] * 2u; n10 = S.row_off(nxt, HALF + RA[0]) + CA[0] * 2u; n11 = S.row_off(nxt, HALF + RA[1]) + CA[1] * 2u; }
            else { n00 = c00; n01 = c01; n10 = c10; n11 = c11; }
        }
        for (int t = 0; t < nt; t += 2) {
            const bool last = (t == nt - 2);
            const char* a1 = cA + (size_t)(t + 1) * kstep;
            const char* a2 = last ? nA : cA + (size_t)(t + 2) * kstep; const char* b2 = last ? nB : cB + (size_t)(t + 2) * kstep;
            const char* a3 = a2 + kstep; const char* b3 = b2 + kstep;
            unsigned v00 = c00, v01 = c01, v10 = c10, v11 = c11;
            if constexpr (GATHER) { if (last) { v00 = n00; v01 = n01; v10 = n10; v11 = n11; } }
            if constexpr (SP2) {
            const int rel = __builtin_amdgcn_readfirstlane(((Epi::NST == 16) && EPI_RELAX && (t == 0) && (ui > 0)) ? 1 : 0);
            PG8_LDB(B0, 0, 0); if constexpr (!HALFN) PG8_LDB(B1, 0, 1); PG8_SCHED; PG8_LDA(At, 0, 0); PG8_STAGE2(PG8_SA(1, 1), a1, c10, c11);
            PG8_WAIT_V8_OR_24(rel);
            PG8_WAIT_L(0); PG8_BAR; PG8_MMA(0, 0, At, B0); if constexpr (!HALFN) PG8_MMA(0, 1, At, B1); PG8_BAR; PG8_SCHED;
            PG8_LDA(At, 0, 1); PG8_STAGE(PG8_SB(0, 0), b2, voffB); PG8_STAGE(PG8_SB(0, 1), b2 + hstepB, voffB); PG8_STAGE2(PG8_SA(0, 0), a2, v00, v01);
            PG8_WAIT_V8_OR_24(rel);
            PG8_WAIT_L(0); PG8_BAR; PG8_MMA(1, 0, At, B0); if constexpr (!HALFN) PG8_MMA(1, 1, At, B1); PG8_BAR; PG8_SCHED;
            PG8_LDB(B0, 1, 0); if constexpr (!HALFN) PG8_LDB(B1, 1, 1); PG8_SCHED; PG8_LDA(At, 1, 0); PG8_STAGE2(PG8_SA(0, 1), a2, v10, v11);
            PG8_WAIT_V(8); PG8_WAIT_L(0); PG8_BAR; PG8_MMA(0, 0, At, B0); if constexpr (!HALFN) PG8_MMA(0, 1, At, B1); PG8_BAR; PG8_SCHED;
            PG8_LDA(At, 1, 1); PG8_STAGE(PG8_SB(1, 0), b3, voffB); PG8_STAGE(PG8_SB(1, 1), b3 + hstepB, voffB); PG8_STAGE2(PG8_SA(1, 0), a3, v00, v01);
            PG8_WAIT_V(8); PG8_WAIT_L(0); PG8_BAR; PG8_MMA(1, 0, At, B0); if constexpr (!HALFN) PG8_MMA(1, 1, At, B1); PG8_BAR; PG8_SCHED;
            } else {
            PG8_LDB(B0, 0, 0); PG8_SCHED; PG8_LDA(At, 0, 0); PG8_STAGE2(PG8_SA(1, 1), a1, c10, c11);
            PG8_WAIT_L(8); PG8_BAR; PG8_WAIT_L(0); PG8_MMA(0, 0, At, B0); PG8_BAR; PG8_SCHED;
            PG8_LDB(B1, 0, 1); PG8_STAGE(PG8_SB(0, 0), b2, voffB);
            PG8_BAR; PG8_WAIT_L(0); PG8_MMA(0, 1, At, B1); PG8_BAR;
            PG8_LDA(At, 0, 1); PG8_STAGE2(PG8_SA(0, 0), a2, v00, v01);
            PG8_BAR; PG8_WAIT_L(0); PG8_MMA(1, 0, At, B0); PG8_BAR; PG8_SCHED;
            PG8_STAGE(PG8_SB(0, 1), b2 + hstepB, voffB);
            PG8_WAIT_V(6); PG8_BAR; PG8_MMA(1, 1, At, B1); PG8_BAR;
            PG8_LDB(B0, 1, 0); PG8_SCHED; PG8_LDA(At, 1, 0); PG8_STAGE2(PG8_SA(0, 1), a2, v10, v11);
            PG8_WAIT_L(8); PG8_BAR; PG8_WAIT_L(0); PG8_MMA(0, 0, At, B0); PG8_BAR; PG8_SCHED;
            PG8_LDB(B1, 1, 1); PG8_STAGE(PG8_SB(1, 0), b3, voffB);
            PG8_BAR; PG8_WAIT_L(0); PG8_MMA(0, 1, At, B1); PG8_BAR;
            PG8_LDA(At, 1, 1); PG8_STAGE2(PG8_SA(1, 0), a3, v00, v01);
            PG8_BAR; PG8_WAIT_L(0); PG8_MMA(1, 0, At, B0); PG8_BAR; PG8_SCHED;
            PG8_STAGE(PG8_SB(1, 1), b3 + hstepB, voffB);
            PG8_WAIT_V(6); PG8_BAR; PG8_MMA(1, 1, At, B1); PG8_BAR;
            }
        }
        if constexpr (ALIGN_EPI) { if (wr == 0) PG8_BAR; }
        E(acc, cur, wr, wc, fr, fq);
        if (!has_next) break;
#pragma unroll
        for (int a = 0; a < 2; ++a)
#pragma unroll
            for (int b = 0; b < 2; ++b)
#pragma unroll
                for (int m = 0; m < 4; ++m)
#pragma unroll
                    for (int n = 0; n < 2; ++n) acc[a][b][m][n] = (f32x4){0.f, 0.f, 0.f, 0.f};
        cur = nxt; cA = nA; cB = nB; ++ui;
        if constexpr (GATHER) { c00 = n00; c01 = n01; c10 = n10; c11 = n11; }
        if constexpr (ALIGN_EPI) { if (wr == 1) PG8_BAR; }
    }
    PG8_WAIT_V(0);
    if constexpr (!ALIGN_EPI) { if (wr == 0) PG8_BAR; }
    PG8_BAR;
#undef PG8_SA
#undef PG8_SB
#undef PG8_STAGE
#undef PG8_STAGE2
#undef PG8_LDA
#undef PG8_LDB
#undef PG8_MMA
#undef PG8_WAIT_V
#undef PG8_WAIT_L
#undef PG8_BAR
#undef PG8_SCHED
}
}

constexpr int NWAVES = 8;
constexpr int BATCH = 4, SEQ = 8192, DM = 2048, T = BATCH * SEQ;
constexpr int AW = 1024, NH = 8, HD = 128, MBLK = 256, NBLK = SEQ / MBLK, TOPK = 3;
constexpr int PW = 1024, NPG = 4, PG = 256;
constexpr int NIN = 3 * AW + PW;
constexpr int NGRP = 8, EPG = 8, NE = 64, DE = 512;
constexpr int PLE = 256;
constexpr float EPS = 1e-6f;
constexpr int NSLOT = 2 * T;
constexpr int PMAX = NSLOT + NE * 256;
constexpr int MAXTILES = PMAX / 256;

constexpr size_t MiB = 1u << 20;
constexpr size_t WS_CTL = 0, CTL_ZERO_BYTES = 1 * MiB;
constexpr size_t WS_WIN = 2 * MiB;
constexpr size_t WS_WPOOL = 18 * MiB;
constexpr size_t WS_WOUT = 19 * MiB;
constexpr size_t WS_WR = 27 * MiB;
constexpr size_t WS_WPG = 28 * MiB;
constexpr size_t WS_WPLE = 36 * MiB;
constexpr size_t WS_WGU = 40 * MiB;
constexpr size_t WS_WD = 296 * MiB;
constexpr size_t WS_XN = 424 * MiB;
constexpr size_t WS_PROJ = 552 * MiB;
constexpr size_t WS_MIX = 808 * MiB;
constexpr size_t WS_Z = 936 * MiB;
constexpr size_t WS_PBF = 1000 * MiB;
constexpr size_t WS_KMEAN = 1016 * MiB;
constexpr size_t WS_RS3 = 1020 * MiB;
constexpr size_t WS_SSQ = 936 * MiB + 8 * MiB;
constexpr size_t WS_RSF = 1021 * MiB;
constexpr size_t WS_ERS = 1024 * MiB;
constexpr size_t WS_RS0 = 1022 * MiB;
constexpr size_t WS_LOGIT = 1060 * MiB;
constexpr size_t WS_ROUTE = 1033 * MiB;
constexpr size_t WS_END = 1057 * MiB;
constexpr size_t RT_ELIST = 0, RT_EWL = 8 * MiB;
constexpr int CW_TMO = 0, CW_CODE = 1;
constexpr int CW_BAR = 4096;
constexpr int CW_ECNT = 16384;
constexpr int CW_EFILL = 16384 + 256;

constexpr int RING_OFF = 0, RING_BYTES = 131072;
constexpr int SCR_BYTES = 133120;
constexpr int LDSCTL_OFF = 135168, MISC_OFF = LDSCTL_OFF;
constexpr int TAB_OFF = LDSCTL_OFF + 256;
constexpr int LDS_BYTES = 163840;

#define GAS __attribute__((address_space(1)))
#define LAS __attribute__((address_space(3)))
typedef unsigned short bf16;
typedef unsigned v4u __attribute__((ext_vector_type(4)));
typedef unsigned v2u __attribute__((ext_vector_type(2)));
typedef float f32x4 __attribute__((ext_vector_type(4)));
typedef GAS unsigned gu32;
#define RLX_AGENT __ATOMIC_RELAXED, __HIP_MEMORY_SCOPE_AGENT
#define LDS_WAIT() asm volatile("s_waitcnt lgkmcnt(0)" ::: "memory")
#define VM_WAIT() asm volatile("s_waitcnt vmcnt(0)" ::: "memory")
typedef float f32x2_t __attribute__((ext_vector_type(2)));
typedef __bf16 bf16x2_t __attribute__((ext_vector_type(2)));
__device__ __forceinline__ unsigned pk2(float lo, float hi) { const f32x2_t v = {lo, hi}; return __builtin_bit_cast(unsigned, __builtin_convertvector(v, bf16x2_t)); }
__device__ __forceinline__ unsigned f2bf(float f) { return pk2(f, 0.f) & 0xffffu; }
__device__ __forceinline__ float bflo(unsigned w) { return __builtin_bit_cast(float, w << 16); }
__device__ __forceinline__ float bfhi(unsigned w) { return __builtin_bit_cast(float, w & 0xffff0000u); }
__device__ __forceinline__ float wave_sum(float v) {
#pragma unroll
    for (int o = 1; o < 64; o <<= 1) v += __shfl_xor(v, o);
    return v;
}
__device__ __forceinline__ float wave_max(float v) {
#pragma unroll
    for (int o = 1; o < 64; o <<= 1) v = fmaxf(v, __shfl_xor(v, o));
    return v;
}
#define XB_TMO      128
#define XB_XCNT(j)  (256  + 64 * (j))
#define XB_XSUB(j)  (1280 + 64 * (j))
#define XB_XGEN(j)  (2304 + 64 * (j))
#define XB_TOP      3328
#define XB_TOPGEN   3392
#define XCD_BAR_WORDS 3456
#define XB_SPIN_CAP (1u << 23)

__device__ __forceinline__ unsigned xb_ld(unsigned* p)              { return __hip_atomic_load(p, __ATOMIC_RELAXED, __HIP_MEMORY_SCOPE_AGENT); }
__device__ __forceinline__ unsigned xb_add(unsigned* p, unsigned v) { return __hip_atomic_fetch_add(p, v, __ATOMIC_RELAXED, __HIP_MEMORY_SCOPE_AGENT); }
__device__ __forceinline__ unsigned xb_xcc_id() { return (unsigned)__builtin_amdgcn_s_getreg((3 << 11) | 20) & 0xFu; }
#define XB_SPIN(cond, bar) do { unsigned _sp = 0; while (cond) { __builtin_amdgcn_s_sleep(1); \
    if ((++_sp & 255u) == 0u) { if (xb_ld(&(bar)[XB_TMO])) break; if (_sp > XB_SPIN_CAP) { atomicAdd(&(bar)[XB_TMO], 1u); break; } } } } while (0)

struct XcdBarrier {
    unsigned* bar; unsigned x;
    volatile LAS unsigned* st;
};

__device__ __forceinline__ XcdBarrier xcd_barrier_post(unsigned* bar, volatile LAS unsigned* st) {
    XcdBarrier b; b.bar = bar; b.x = xb_xcc_id(); b.st = st;
    if (threadIdx.x == 0) (void)xb_add(&bar[XB_XCNT(b.x)], 1u);
    return b;
}
__device__ __forceinline__ void xcd_barrier_complete(unsigned* bar, unsigned x, unsigned& nloc, unsigned& nx) {
    const unsigned G = gridDim.x * gridDim.y * gridDim.z;
    unsigned sum, cnt, mine, sp = 0u;
    for (;;) {
        sum = 0u; cnt = 0u; mine = 0u;
#pragma unroll
        for (unsigned j = 0; j < 16; ++j) { const unsigned c = xb_ld(&bar[XB_XCNT(j)]); sum += c; cnt += (c > 0u) ? 1u : 0u; mine = (j == x) ? c : mine; }
        if (sum == G) break;
        __builtin_amdgcn_s_sleep(1);
        if ((++sp & 255u) == 0u) { if (xb_ld(&bar[XB_TMO])) break; if (sp > XB_SPIN_CAP) { atomicAdd(&bar[XB_TMO], 1u); break; } }
    }
    nloc = mine > 0u ? mine : 1u; nx = cnt > 0u ? cnt : 1u;
}

__device__ __forceinline__ void xcd_barrier(const XcdBarrier& b) {
    asm volatile("s_waitcnt vmcnt(0)" ::: "memory");
    __syncthreads();
    if (threadIdx.x == 0) {
        unsigned* bar = b.bar;
        __builtin_amdgcn_s_waitcnt(0);
        unsigned nloc = b.st[0], nx = b.st[1];
        if (nloc == 0u) { xcd_barrier_complete(bar, b.x, nloc, nx); b.st[0] = nloc; b.st[1] = nx; }
        const unsigned old = xb_add(&bar[XB_XSUB(b.x)], 1u);
        const unsigned gen = old / nloc;
        if (old + 1u == (gen + 1u) * nloc) {
            __builtin_amdgcn_fence(__ATOMIC_RELEASE, "agent");
            asm volatile("s_waitcnt vmcnt(0)" ::: "memory");
            const unsigned og = xb_add(&bar[XB_TOP], 1u);
            const unsigned tg = og / nx;
            if (og + 1u == (tg + 1u) * nx) xb_add(&bar[XB_TOPGEN], 1u);
            else XB_SPIN(xb_ld(&bar[XB_TOPGEN]) == tg, bar);
            __builtin_amdgcn_fence(__ATOMIC_ACQUIRE, "agent");
            xb_add(&bar[XB_XGEN(b.x)], 1u);
            asm volatile("s_waitcnt vmcnt(0)" ::: "memory");
        } else {
            XB_SPIN(xb_ld(&bar[XB_XGEN(b.x)]) == gen, bar);
            __builtin_amdgcn_fence(__ATOMIC_ACQUIRE, "agent");
            asm volatile("s_waitcnt vmcnt(0)" ::: "memory");
        }
    }
    __syncthreads();
}

struct Frame {
    LAS unsigned char* lds; unsigned char* ldsg;
    volatile LAS unsigned* MISC;
    gu32* ctl;
    int tid, lane, wave;
    int vcu, G;
    const float *x, *p, *g_mix, *w_in, *beta_attn, *w_pool, *pool_scale, *w_out, *g_ffn, *w_rg, *b_rg, *w_re, *b_re, *w_eg, *w_eu, *w_ed, *g_ple, *w_ple, *w_pg, *b_pg, *g_final;
    float* out; unsigned char* ws;
};
#define WSP(T_, off) ((T_*)(F.ws + (off)))

struct KmId { __device__ __forceinline__ int operator()(int k) const { return k; } };
struct KmAttn { __device__ __forceinline__ int operator()(int k) const { return k < AW ? ((k & ~127) + 32 * (k & 3) + ((k & 127) >> 2)) : k; } };
template <class RowMap, class KMap = KmId>
__device__ __forceinline__ void tr64_item(const float* W, int ldw, bf16* WT, int ldt, int k0, int n0, const RowMap& rm, LAS float* scr, int lane, const KMap& km = KMap(), const float* kg = nullptr) {
    f32x4 v[16];
#pragma unroll
    for (int i = 0; i < 16; ++i) { const int k = 4 * i + (lane >> 4), n4 = (lane & 15) * 4; v[i] = *(const GAS f32x4*)(W + (size_t)km(k0 + k) * ldw + n0 + n4); }
#pragma unroll
    for (int i = 0; i < 16; ++i) { const int k = 4 * i + (lane >> 4), n4 = (lane & 15) * 4;
        LAS float* s = scr + k * 65 + n4; const float gk = kg ? kg[k0 + k] : 1.f; s[0] = v[i].x * gk; s[1] = v[i].y * gk; s[2] = v[i].z * gk; s[3] = v[i].w * gk; }
    LDS_WAIT();
    const int c = lane & 7;
#pragma unroll
    for (int j = 0; j < 8; ++j) { const int n = (lane >> 3) + 8 * j; const LAS float* s = scr + (8 * c) * 65 + n;
        v4u o; o.x = pk2(s[0 * 65], s[1 * 65]); o.y = pk2(s[2 * 65], s[3 * 65]); o.z = pk2(s[4 * 65], s[5 * 65]); o.w = pk2(s[6 * 65], s[7 * 65]);
        *(GAS v4u*)(WT + (size_t)rm(n0 + n) * ldt + k0 + 8 * c) = o; }
    LDS_WAIT();
}
struct RmId { __device__ __forceinline__ int operator()(int n) const { return n; } };
template <class KMap = KmId>
__device__ __forceinline__ void tr64_load(const float* W, int ldw, int k0, int n0, int lane, f32x4 (&v)[16], const KMap& km = KMap()) {
#pragma unroll
    for (int i = 0; i < 16; ++i) { const int k = 4 * i + (lane >> 4), n4 = (lane & 15) * 4; v[i] = __builtin_nontemporal_load((const GAS f32x4*)(W + (size_t)km(k0 + k) * ldw + n0 + n4)); }
}
template <class RowMap>
__device__ __forceinline__ void tr64_finish(const f32x4 (&v)[16], bf16* WT, int ldt, int k0, int n0, const RowMap& rm, LAS float* scr, int lane, const LAS float* lg, int gsel) {
    const float gm_ = gsel >= 0 ? 1.f : 0.f; const LAS float* gp_ = lg + (gsel > 0 ? 2048 : 0);
#pragma unroll
    for (int i = 0; i < 16; ++i) { const int k = 4 * i + (lane >> 4), n4 = (lane & 15) * 4;
        LAS float* s = scr + k * 65 + n4; const float gk = fmaf(gp_[k0 + k], gm_, 1.f - gm_); s[0] = v[i].x * gk; s[1] = v[i].y * gk; s[2] = v[i].z * gk; s[3] = v[i].w * gk; }
    LDS_WAIT();
    const int c = lane & 7;
#pragma unroll
    for (int j = 0; j < 8; ++j) { const int n = (lane >> 3) + 8 * j; const LAS float* s = scr + (8 * c) * 65 + n;
        v4u o; o.x = pk2(s[0 * 65], s[1 * 65]); o.y = pk2(s[2 * 65], s[3 * 65]); o.z = pk2(s[4 * 65], s[5 * 65]); o.w = pk2(s[6 * 65], s[7 * 65]);
        __builtin_nontemporal_store(o, (GAS v4u*)(WT + (size_t)rm(n0 + n) * ldt + k0 + 8 * c)); }
    LDS_WAIT();
}

struct RmGU { int add; __device__ __forceinline__ int operator()(int n) const { return ((n >> 2) << 3) + (n & 3) + add; } };

__device__ __forceinline__ void row_load(const float* row, int lane, f32x4 (&v)[8]) {
    const GAS f32x4* xr = (const GAS f32x4*)row + lane;
#pragma unroll
    for (int j = 0; j < 8; ++j) v[j] = xr[64 * j];
}
__device__ __forceinline__ void row_load_nt(const float* row, int lane, f32x4 (&v)[8]) {
    const GAS f32x4* xr = (const GAS f32x4*)row + lane;
#pragma unroll
    for (int j = 0; j < 8; ++j) v[j] = __builtin_nontemporal_load(xr + 64 * j);
}
__device__ __forceinline__ float row_ss(const f32x4 (&v)[8]) {
    float s = 0.f;
#pragma unroll
    for (int j = 0; j < 8; ++j) s += (v[j].x * v[j].x + v[j].y * v[j].y) + (v[j].z * v[j].z + v[j].w * v[j].w);
    return wave_sum(s);
}
__device__ __forceinline__ void row_norm_bf16(const f32x4 (&v)[8], float ss, const float* gain, bf16* orow, int lane) {
    const float r = 1.0f / sqrtf(ss * (1.f / DM) + EPS);
    GAS unsigned long long* o8 = (GAS unsigned long long*)orow + lane;
    const GAS f32x4* g4 = (const GAS f32x4*)gain + lane;
#pragma unroll
    for (int j = 0; j < 8; ++j) { const f32x4 g = g4[64 * j];
        o8[64 * j] = (unsigned long long)pk2(v[j].x * r * g.x, v[j].y * r * g.y) | ((unsigned long long)pk2(v[j].z * r * g.z, v[j].w * r * g.w) << 32); }
}

__device__ __forceinline__ void row_norm_bf16_g(const f32x4 (&v)[8], float ss, const f32x4 (&g)[8], bf16* orow, int lane) {
    const float r = 1.0f / sqrtf(ss * (1.f / DM) + EPS);
    GAS unsigned long long* o8 = (GAS unsigned long long*)orow + lane;
#pragma unroll
    for (int j = 0; j < 8; ++j)
        o8[64 * j] = (unsigned long long)pk2(v[j].x * r * g[j].x, v[j].y * r * g[j].y) | ((unsigned long long)pk2(v[j].z * r * g[j].z, v[j].w * r * g[j].w) << 32);
}
__device__ __forceinline__ void p0_prologue(Frame& F) {
    LAS float* scr = (LAS float*)(F.lds + F.wave * 16640);
    const int gw = F.vcu * NWAVES + F.wave, NGW = F.G * NWAVES;
    constexpr int I_WIN = 32 * 64;
    for (int it = gw; it < I_WIN; it += NGW) tr64_item(F.w_in, NIN, WSP(bf16, WS_WIN), DM, 64 * (it / 64), 64 * (it % 64), RmId{}, scr, F.lane, KmId{}, F.g_mix);
    const int gt = F.vcu * (NWAVES * 64) + F.tid, NGT = F.G * NWAVES * 64;
    { bf16* wr = WSP(bf16, WS_WR);
      for (int i = gt; i < 256 * DM; i += NGT) { const int n = i / DM, k = i % DM; float v = 0.f;
          if (n < 8) v = F.w_rg[k * 8 + n]; else if (n < 72) { const int g = (n - 8) >> 3, e = (n - 8) & 7; v = F.w_re[((size_t)g * DM + k) * 8 + e]; }
          wr[i] = (bf16)f2bf(v * F.g_ffn[k]); } }
    { const GAS f32x4* ps = (const GAS f32x4*)F.p; GAS v2u* pd = (GAS v2u*)WSP(bf16, WS_PBF);
      static_assert((T * PLE / 4) % (256 * NWAVES * 64 * 8) == 0, "p copy: eight loads per trip");
      if (F.G == 256) {
        for (int i = gt; i < T * PLE / 4; i += 8 * NGT) { f32x4 v[8];
#pragma unroll
            for (int k = 0; k < 8; ++k) v[k] = __builtin_nontemporal_load(ps + i + k * NGT);
#pragma unroll
            for (int k = 0; k < 8; ++k) { v2u o; o.x = pk2(v[k].x, v[k].y); o.y = pk2(v[k].z, v[k].w); pd[i + k * NGT] = o; } }
      } else for (int i = gt; i < T * PLE / 4; i += NGT) { const f32x4 v = ps[i]; v2u o; o.x = pk2(v.x, v.y); o.y = pk2(v.z, v.w); pd[i] = o; } }
    { float* ones = WSP(float, WS_RS0) + 65536; for (int i = gt; i < T; i += NGT) ones[i] = 1.0f; }
    { f32x4 v[8]; row_load_nt(F.x + (size_t)gw * DM, F.lane, v); VM_WAIT();
      for (int m = gw; m < T; m += NGW) { const int mn = (m + NGW < T) ? m + NGW : m; f32x4 vn[8]; row_load_nt(F.x + (size_t)mn * DM, F.lane, vn);
          const float ss = row_ss(v); if (F.lane == 0) WSP(float, WS_RS0)[m] = 1.0f / sqrtf(ss * (1.f / DM) + EPS);
          { GAS unsigned long long* o8 = (GAS unsigned long long*)(WSP(bf16, WS_XN) + (size_t)m * DM) + F.lane;
#pragma unroll
            for (int j = 0; j < 8; ++j) o8[64 * j] = (unsigned long long)pk2(v[j].x, v[j].y) | ((unsigned long long)pk2(v[j].z, v[j].w) << 32); }
#pragma unroll
          for (int j = 0; j < 8; ++j) v[j] = vn[j]; } }
}

struct ConvItem { const float* W; bf16* WT; int ldw, ldt, k0, n0, add, kperm, gsel; };
__device__ __forceinline__ ConvItem conv_item(Frame& F, int it) {
    constexpr int I_POOL = 4 * 16, I_WOUT = 32 * 32, I_WPG = 32 * 32, I_WPLE = 4 * 32, I_EG = 64 * 256; ConvItem c; int r = it; c.add = -1; c.kperm = 0; c.gsel = -1;
    if (r < I_POOL) { const int g = r / 16, q = r % 16; c.W = F.w_pool + (size_t)g * PG * PG; c.ldw = PG; c.WT = WSP(bf16, WS_WPOOL) + (size_t)g * PG * PG; c.ldt = PG; c.k0 = 64 * (q / 4); c.n0 = 64 * (q % 4); return c; } r -= I_POOL;
    if (r < I_WOUT) { c.W = F.w_out; c.ldw = DM; c.WT = WSP(bf16, WS_WOUT); c.ldt = DM; c.k0 = 64 * (r / 32); c.n0 = 64 * (r % 32); c.kperm = 1; return c; } r -= I_WOUT;
    if (r < I_WPG) { c.W = F.w_pg; c.ldw = DM; c.WT = WSP(bf16, WS_WPG); c.ldt = DM; c.k0 = 64 * (r / 32); c.n0 = 64 * (r % 32); c.gsel = 1; return c; } r -= I_WPG;
    if (r < I_WPLE) { c.W = F.w_ple; c.ldw = DM; c.WT = WSP(bf16, WS_WPLE); c.ldt = PLE; c.k0 = 64 * (r / 32); c.n0 = 64 * (r % 32); return c; } r -= I_WPLE;
    if (r < 2 * I_EG) { const bool up = r >= I_EG; r -= up ? I_EG : 0; const int e = r / 256, q = r % 256;
        c.W = (up ? F.w_eu : F.w_eg) + (size_t)e * DM * DE; c.ldw = DE; c.WT = WSP(bf16, WS_WGU) + (size_t)e * 1024 * DM; c.ldt = DM; { const int g = q >> 3, w = q & 7; c.k0 = 64 * (4 * (g >> 2) + (w >> 1)); c.n0 = 64 * (2 * (g & 3) + (w & 1)); }        c.add = up ? 4 : 0; c.gsel = 0; return c; }
    r -= 2 * I_EG; { const int e = r / 256, q = r % 256;
        c.W = F.w_ed + (size_t)e * DE * DM; c.ldw = DM; c.WT = WSP(bf16, WS_WD) + (size_t)e * DM * DE; c.ldt = DE; { const int g = q >> 3, w = q & 7; c.k0 = 64 * (4 * (g >> 4) + (w >> 1)); c.n0 = 64 * (2 * (g & 15) + (w & 1)); } }
    return c;
}
struct RmAny { int add; __device__ __forceinline__ int operator()(int n) const { return add < 0 ? n : ((n >> 2) << 3) + (n & 3) + add; } };
struct KmAny { int on; __device__ __forceinline__ int operator()(int k) const { return (on && k < AW) ? ((k & ~127) + 32 * (k & 3) + ((k & 127) >> 2)) : k; } };
__device__ __forceinline__ void conv_experts(Frame& F, int part, int nparts) {
    LAS float* scr = (LAS float*)(F.lds + F.wave * 16640);
    constexpr int NITEMS = 4 * 16 + 32 * 32 + 32 * 32 + 4 * 32 + 3 * 64 * 256; const int step = nparts * NWAVES;
    LAS float* lg = (LAS float*)(F.lds + 143360);
    for (int i = F.tid; i < DM; i += NWAVES * 64) { lg[i] = F.g_ffn[i]; lg[DM + i] = F.g_ple[i]; }
    __syncthreads();
    int it = part * NWAVES + F.wave;
    f32x4 va[16], vb[16];
#define CV_LOAD(buf, idx) do { const int id_ = (idx) < NITEMS ? (idx) : NITEMS - 1;        \
        const ConvItem c_ = conv_item(F, id_); tr64_load(c_.W, c_.ldw, c_.k0, c_.n0, F.lane, buf, KmAny{c_.kperm}); } while (0)
#define CV_FIN(buf, idx) do { const ConvItem c_ = conv_item(F, (idx)); tr64_finish(buf, c_.WT, c_.ldt, c_.k0, c_.n0, RmAny{c_.add}, scr, F.lane, lg, c_.gsel); } while (0)
    CV_LOAD(va, it);
    while (it < NITEMS) {
        CV_LOAD(vb, it + step); CV_FIN(va, it); it += step; if (it >= NITEMS) break;
        CV_LOAD(va, it + step); CV_FIN(vb, it); it += step;
    }
#undef CV_LOAD
#undef CV_FIN
}
struct SplitSched {
    pg8::TileOrder ord; const char* A; const char* Bt; size_t a_tile, b_tile; int NC, K1;
    __device__ __forceinline__ bool next(int i, pg8::Unit& u) const {
        int L;
        if (i < K1) L = i * ord.G + ord.c; else { if (ord.c < NC) return false; L = K1 * ord.G + (i - K1) * (ord.G - NC) + (ord.c - NC); }
        int pm, pn; if (!ord.map((long)L, pm, pn)) return false; u.pm = pm; u.pn = pn; u.x0 = 0; u.x1 = 0;
        u.a = A + (size_t)pm * a_tile; u.b = Bt + (size_t)pn * b_tile; return true; }
    __device__ __forceinline__ unsigned row_off(const pg8::Unit&, int) const { return 0u; }
};

struct DenseSched {
    pg8::TileOrder ord; const char* A; const char* Bt; size_t a_tile, b_tile; size_t a_pn_off;
    __device__ __forceinline__ bool next(int i, pg8::Unit& u) const { int pm, pn; if (!ord.tile(i, pm, pn)) return false; u.pm = pm; u.pn = pn; u.x0 = 0; u.x1 = 0;
        u.a = A + (size_t)pm * a_tile + (size_t)pn * a_pn_off; u.b = Bt + (size_t)pn * b_tile; return true; }
    __device__ __forceinline__ unsigned row_off(const pg8::Unit&, int) const { return 0u; }
};
struct MoeSched {
    int TT, NCT, G, c; const LAS int* tile_e; const char* A; const char* Bt; size_t b_exp, b_ct; size_t a_tile; const int* elist; unsigned a_row;
    __device__ __forceinline__ bool next(int i, pg8::Unit& u) const {
        const int L = i * G + c; if (L >= TT * NCT) return false; const int tile = L / NCT, ct = L % NCT; const int e = tile_e[tile];
        const int l0 = (tile - tile_e[MAXTILES + e]) * 256; const int nv = tile_e[MAXTILES + 160 + e] - l0;
        u.pm = nv < 256 ? nv : 256; u.pn = ct; u.x0 = tile * 256; u.x1 = e * T + l0; u.b = Bt + (size_t)e * b_exp + (size_t)ct * b_ct; u.a = A + (size_t)tile * a_tile; return true; }
    __device__ __forceinline__ unsigned row_off(const pg8::Unit& u, int r) const { const int s = elist[u.x1 + (r < u.pm ? r : u.pm - 1)]; return (unsigned)(s >> 1) * a_row; }
};
__device__ __forceinline__ int build_tile_table(Frame& F) {
    LAS int* tab = (LAS int*)(F.lds + TAB_OFF);
    __syncthreads();
    if (F.tid < 64) { const unsigned c = __hip_atomic_load(F.ctl + CW_ECNT + F.tid, RLX_AGENT); tab[MAXTILES + 80 + F.tid] = (int)((c + 255u) >> 8); tab[MAXTILES + 160 + F.tid] = (int)c; }
    __syncthreads();
    if (F.tid == 0) { int s = 0; for (int e = 0; e < 64; ++e) { tab[MAXTILES + e] = s; s += tab[MAXTILES + 80 + e]; } tab[MAXTILES + 64] = s; }
    __syncthreads();
    const int TT = tab[MAXTILES + 64];
    if (F.tid < MAXTILES) { int e = 0; for (int k = 1; k < 64; ++k) e += (tab[MAXTILES + k] <= F.tid) ? 1 : 0; tab[F.tid] = e; }
    __syncthreads();
    return TT;
}

using pg8::f32x4; using pg8::Unit; using pg8::cvt_pk_bf16; using pg8::u32x4; using pg8::u32x2;
template <bool NTS = false> struct EpiBf16T {
    static constexpr bool PERM = true; static constexpr int NST = 16;
    bf16* O; int ldc; int col_base;
    const float* rs;
    __device__ __forceinline__ void operator()(const f32x4 (&acc)[2][2][4][2], const Unit& u, int wr, int wc, int fr, int fq) const {
        const int row0 = u.pm * 256 + wr * 64 + fr, col0 = col_base + u.pn * 256 + wc * 32 + 8 * fq;
        float rsv[2][4];
#pragma unroll
        for (int ai = 0; ai < 2; ++ai)
#pragma unroll
            for (int m = 0; m < 4; ++m) rsv[ai][m] = rs[row0 + ai * 128 + m * 16];
#pragma unroll
        for (int ai = 0; ai < 2; ++ai)
#pragma unroll
            for (int m = 0; m < 4; ++m) { bf16* rowp = O + (size_t)(row0 + ai * 128 + m * 16) * ldc + col0; const float r_ = rsv[ai][m];
#pragma unroll
                for (int bj = 0; bj < 2; ++bj) { const f32x4 v0 = acc[ai][bj][m][0] * r_, v1 = acc[ai][bj][m][1] * r_;
                    u32x4 w; w.x = cvt_pk_bf16(v0[0], v0[1]); w.y = cvt_pk_bf16(v0[2], v0[3]); w.z = cvt_pk_bf16(v1[0], v1[1]); w.w = cvt_pk_bf16(v1[2], v1[3]);
                    if (NTS) { const bf16* p_ = rowp + bj * 128; asm volatile("global_store_dwordx4 %0, %1, off nt\n\ts_nop 1" :: "v"(p_), "v"(w) : "memory"); }
                    else *(GAS u32x4*)(rowp + bj * 128) = w; } }
    }
};
typedef EpiBf16T<false> EpiBf16;
#ifndef EPI_BATCH
#define EPI_BATCH 1
#endif
#if EPI_BATCH
#define EPI_SCHED_BARRIER __builtin_amdgcn_sched_barrier(0)
#else
#define EPI_SCHED_BARRIER do {} while (0)
#endif
struct EpiResBf16 {
    static constexpr bool PERM = true; static constexpr int NST = 16;
    const bf16* base; bf16* C; int ldc; float* ssq;
    __device__ __forceinline__ void operator()(const f32x4 (&acc)[2][2][4][2], const Unit& u, int wr, int wc, int fr, int fq) const {
        const int row0 = u.pm * 256 + wr * 64 + fr, col0 = u.pn * 256 + wc * 32 + 8 * fq;
        float* sq = ssq + (size_t)(4 * u.pn + wc) * T;
#pragma unroll
        for (int ai = 0; ai < 2; ++ai) {
            u32x4 bw[4][2];
#pragma unroll
            for (int m = 0; m < 4; ++m) { const size_t ro = (size_t)(row0 + ai * 128 + m * 16) * ldc + col0;
#pragma unroll
                for (int bj = 0; bj < 2; ++bj) bw[m][bj] = __builtin_nontemporal_load((const GAS u32x4*)(base + ro + bj * 128)); }
            EPI_SCHED_BARRIER;
#pragma unroll
            for (int m = 0; m < 4; ++m) { const size_t ro = (size_t)(row0 + ai * 128 + m * 16) * ldc + col0; float ss = 0.f;
#pragma unroll
                for (int bj = 0; bj < 2; ++bj) {
                    const u32x4 xw = bw[m][bj]; const f32x4 x0 = {bflo(xw.x), bfhi(xw.x), bflo(xw.y), bfhi(xw.y)}, x1 = {bflo(xw.z), bfhi(xw.z), bflo(xw.w), bfhi(xw.w)};
                    const f32x4 v0 = acc[ai][bj][m][0] + x0, v1 = acc[ai][bj][m][1] + x1;
                    ss += (v0[0] * v0[0] + v0[1] * v0[1]) + (v0[2] * v0[2] + v0[3] * v0[3]) + (v1[0] * v1[0] + v1[1] * v1[1]) + (v1[2] * v1[2] + v1[3] * v1[3]);
                    u32x4 w; w.x = cvt_pk_bf16(v0[0], v0[1]); w.y = cvt_pk_bf16(v0[2], v0[3]); w.z = cvt_pk_bf16(v1[0], v1[1]); w.w = cvt_pk_bf16(v1[2], v1[3]);
                    *(GAS u32x4*)(C + ro + bj * 128) = w; }
                ss += __shfl_xor(ss, 16); ss += __shfl_xor(ss, 32);
                if (fq == 0) sq[row0 + ai * 128 + m * 16] = ss; }
            EPI_SCHED_BARRIER;
        }
    }
};
struct EpiLogit {
    static constexpr bool PERM = false; static constexpr int NST = 16;
    float* C;
    __device__ __forceinline__ void operator()(const f32x4 (&acc)[2][2][4][2], const Unit& u, int wr, int wc, int fr, int fq) const {
        const int row0 = u.pm * 256 + wr * 64 + fr, col0 = wc * 32 + 4 * fq; float* Cb = C + (size_t)u.pn * T * 128;
#pragma unroll
        for (int ai = 0; ai < 2; ++ai)
#pragma unroll
            for (int m = 0; m < 4; ++m) { float* rowp = Cb + (size_t)(row0 + ai * 128 + m * 16) * 128 + col0;
#pragma unroll
                for (int n = 0; n < 2; ++n) *(GAS f32x4*)(rowp + n * 16) = acc[ai][0][m][n]; }
    }
};
struct EpiGU {
    static constexpr bool PERM = true; static constexpr int NST = 16;
    bf16* H; const float* ers;
    __device__ __forceinline__ void operator()(const f32x4 (&acc)[2][2][4][2], const Unit& u, int wr, int wc, int fr, int fq) const {
        const int row0 = u.x0 + wr * 64 + fr, col0 = u.pn * 128 + wc * 16 + 4 * fq;
        float rsv[2][4];
#pragma unroll
        for (int ai = 0; ai < 2; ++ai)
#pragma unroll
            for (int m = 0; m < 4; ++m) { const int r = wr * 64 + fr + ai * 128 + m * 16; rsv[ai][m] = ers[u.x1 + (r < u.pm ? r : u.pm - 1)]; }
#pragma unroll
        for (int ai = 0; ai < 2; ++ai)
#pragma unroll
            for (int m = 0; m < 4; ++m) { bf16* rowp = H + (size_t)(row0 + ai * 128 + m * 16) * DE + col0; const float rs = rsv[ai][m];
#pragma unroll
                for (int bj = 0; bj < 2; ++bj) { const f32x4 g = acc[ai][bj][m][0] * rs, up = acc[ai][bj][m][1] * rs; float h[4];
#pragma unroll
                    for (int j = 0; j < 4; ++j) h[j] = g[j] * __builtin_amdgcn_rcpf(1.0f + __expf(-g[j])) * up[j];
                    u32x2 w; w.x = cvt_pk_bf16(h[0], h[1]); w.y = cvt_pk_bf16(h[2], h[3]);
                    *(GAS u32x2*)(rowp + bj * 64) = w; } }
    }
};
struct EpiDown {
    static constexpr bool PERM = true; static constexpr int NST = 16;
    bf16* Y; const int* elist; const float* ewl; bf16* dummy;
    __device__ __forceinline__ void operator()(const f32x4 (&acc)[2][2][4][2], const Unit& u, int wr, int wc, int fr, int fq) const {
        const int col0 = u.pn * 256 + wc * 32 + 8 * fq;
        int sl[2][4]; float wv[2][4];
#pragma unroll
        for (int ai = 0; ai < 2; ++ai)
#pragma unroll
            for (int m = 0; m < 4; ++m) { const int r = wr * 64 + fr + ai * 128 + m * 16; const int ix = u.x1 + (r < u.pm ? r : u.pm - 1); const int s_ = elist[ix]; sl[ai][m] = r < u.pm ? s_ : -1; wv[ai][m] = ewl[ix]; }
#pragma unroll
        for (int ai = 0; ai < 2; ++ai)
#pragma unroll
            for (int m = 0; m < 4; ++m) { const int slot = sl[ai][m]; const float w = wv[ai][m]; const int r = wr * 64 + fr + ai * 128 + m * 16;
                bf16* rowp = (slot >= 0 ? Y + (size_t)slot * DM : dummy + (size_t)r * DM) + col0;
#pragma unroll
                for (int bj = 0; bj < 2; ++bj) { const f32x4 v0 = acc[ai][bj][m][0] * w, v1 = acc[ai][bj][m][1] * w;
                    u32x4 o; o.x = cvt_pk_bf16(v0[0], v0[1]); o.y = cvt_pk_bf16(v0[2], v0[3]); o.z = cvt_pk_bf16(v1[0], v1[1]); o.w = cvt_pk_bf16(v1[2], v1[3]);
                    __builtin_nontemporal_store(o, (GAS u32x4*)(rowp + bj * 128)); } }
    }
};
struct EpiPle {
    static constexpr bool PERM = true; static constexpr int NST = 16;
    const bf16* H2; bf16* H3; const bf16* PE; const float* bias; const float* rs;
    __device__ __forceinline__ void operator()(const f32x4 (&acc)[2][2][4][2], const Unit& u, int wr, int wc, int fr, int fq) const {
        const int row0 = u.pm * 256 + wr * 64 + fr, col0 = u.pn * 256 + wc * 32 + 8 * fq;
        f32x4 bv[2][2];
#pragma unroll
        for (int bj = 0; bj < 2; ++bj)
#pragma unroll
            for (int n = 0; n < 2; ++n) bv[bj][n] = *(const GAS f32x4*)(bias + col0 + bj * 128 + n * 4);
#pragma unroll
        for (int ai = 0; ai < 2; ++ai) {
            u32x4 hw[4][2], pw[4][2]; float rsv[4];
#pragma unroll
            for (int m = 0; m < 4; ++m) rsv[m] = rs[row0 + ai * 128 + m * 16];
#pragma unroll
            for (int m = 0; m < 4; ++m) { const size_t ro = (size_t)(row0 + ai * 128 + m * 16) * DM + col0;
#pragma unroll
                for (int bj = 0; bj < 2; ++bj) { const size_t o = ro + bj * 128; hw[m][bj] = __builtin_nontemporal_load((const GAS u32x4*)(H2 + o)); pw[m][bj] = __builtin_nontemporal_load((const GAS u32x4*)(PE + o)); } }
            EPI_SCHED_BARRIER;
#pragma unroll
            for (int m = 0; m < 4; ++m) { const size_t ro = (size_t)(row0 + ai * 128 + m * 16) * DM + col0;
#pragma unroll
                for (int bj = 0; bj < 2; ++bj) { const size_t o = ro + bj * 128; const u32x4 h = hw[m][bj], q = pw[m][bj];
                    const f32x4 a0 = acc[ai][bj][m][0] * rsv[m] + bv[bj][0], a1 = acc[ai][bj][m][1] * rsv[m] + bv[bj][1];
                    float r[8];
                    r[0] = bflo(h.x) + bflo(q.x) * __builtin_amdgcn_rcpf(1.0f + __expf(-a0[0])); r[1] = bfhi(h.x) + bfhi(q.x) * __builtin_amdgcn_rcpf(1.0f + __expf(-a0[1]));
                    r[2] = bflo(h.y) + bflo(q.y) * __builtin_amdgcn_rcpf(1.0f + __expf(-a0[2])); r[3] = bfhi(h.y) + bfhi(q.y) * __builtin_amdgcn_rcpf(1.0f + __expf(-a0[3]));
                    r[4] = bflo(h.z) + bflo(q.z) * __builtin_amdgcn_rcpf(1.0f + __expf(-a1[0])); r[5] = bfhi(h.z) + bfhi(q.z) * __builtin_amdgcn_rcpf(1.0f + __expf(-a1[1]));
                    r[6] = bflo(h.w) + bflo(q.w) * __builtin_amdgcn_rcpf(1.0f + __expf(-a1[2])); r[7] = bfhi(h.w) + bfhi(q.w) * __builtin_amdgcn_rcpf(1.0f + __expf(-a1[3]));
                    u32x4 w; w.x = cvt_pk_bf16(r[0], r[1]); w.y = cvt_pk_bf16(r[2], r[3]); w.z = cvt_pk_bf16(r[4], r[5]); w.w = cvt_pk_bf16(r[6], r[7]);
                    *(GAS u32x4*)(H3 + o) = w; } }
            EPI_SCHED_BARRIER;
        }
    }
};

__device__ __forceinline__ void row_load_bf(const bf16* row, int lane, float (&f)[4][8]) {
    const GAS v4u* r4 = (const GAS v4u*)row + lane;
#pragma unroll
    for (int j = 0; j < 4; ++j) { const v4u w = r4[64 * j];
        f[j][0] = bflo(w.x); f[j][1] = bfhi(w.x); f[j][2] = bflo(w.y); f[j][3] = bfhi(w.y); f[j][4] = bflo(w.z); f[j][5] = bfhi(w.z); f[j][6] = bflo(w.w); f[j][7] = bfhi(w.w); }
}
__device__ __forceinline__ void row_load_bf_nt(const bf16* row, int lane, float (&f)[4][8]) {
    const GAS v4u* r4 = (const GAS v4u*)row + lane;
#pragma unroll
    for (int j = 0; j < 4; ++j) { const v4u w = __builtin_nontemporal_load(r4 + 64 * j);
        f[j][0] = bflo(w.x); f[j][1] = bfhi(w.x); f[j][2] = bflo(w.y); f[j][3] = bfhi(w.y); f[j][4] = bflo(w.z); f[j][5] = bfhi(w.z); f[j][6] = bflo(w.w); f[j][7] = bfhi(w.w); }
}
__device__ __forceinline__ void row_ldp(const bf16* row, int lane, v4u (&w)[4]) {
    const GAS v4u* r4 = (const GAS v4u*)row + lane;
#pragma unroll
    for (int j = 0; j < 4; ++j) w[j] = r4[64 * j];
}
__device__ __forceinline__ void row_ldp_nt(const bf16* row, int lane, v4u (&w)[4]) {
    const GAS v4u* r4 = (const GAS v4u*)row + lane;
#pragma unroll
    for (int j = 0; j < 4; ++j) w[j] = __builtin_nontemporal_load(r4 + 64 * j);
}
__device__ __forceinline__ void row_unpack(const v4u (&w)[4], float (&f)[4][8]) {
#pragma unroll
    for (int j = 0; j < 4; ++j) { f[j][0] = bflo(w[j].x); f[j][1] = bfhi(w[j].x); f[j][2] = bflo(w[j].y); f[j][3] = bfhi(w[j].y); f[j][4] = bflo(w[j].z); f[j][5] = bfhi(w[j].z); f[j][6] = bflo(w[j].w); f[j][7] = bfhi(w[j].w); }
}
__device__ __forceinline__ float row_ss_bf(const float (&f)[4][8]) {
    float s = 0.f;
#pragma unroll
    for (int j = 0; j < 4; ++j)
#pragma unroll
        for (int k = 0; k < 8; ++k) s += f[j][k] * f[j][k];
    return wave_sum(s);
}
__device__ __forceinline__ void row_norm_bf_store(const float (&f)[4][8], float ss, const float* gain, bf16* orow, int lane) {
    const float r = 1.0f / sqrtf(ss * (1.f / DM) + EPS);
    GAS v4u* o4 = (GAS v4u*)orow + lane;
#pragma unroll
    for (int j = 0; j < 4; ++j) { const GAS f32x4* g4 = (const GAS f32x4*)(gain + (64 * j + lane) * 8); const f32x4 g0 = g4[0], g1 = g4[1]; v4u o;
        o.x = pk2(f[j][0] * r * g0.x, f[j][1] * r * g0.y); o.y = pk2(f[j][2] * r * g0.z, f[j][3] * r * g0.w);
        o.z = pk2(f[j][4] * r * g1.x, f[j][5] * r * g1.y); o.w = pk2(f[j][6] * r * g1.z, f[j][7] * r * g1.w); o4[64 * j] = o; }
}

template <int WIN>
__device__ __forceinline__ void z_load(const bf16* proj, int tp, int g, int lane, v4u (&w)[WIN]) {
    const int t = 2 * tp + (lane >> 5), c8 = g * PG + (lane & 31) * 8, pos = t & (SEQ - 1);
    const bf16* up = proj + (size_t)t * NIN + 3 * AW + c8;
#pragma unroll
    for (int d = 0; d < WIN; ++d) { const int dd = (d <= pos) ? d : 0; w[d] = *(const GAS v4u*)(up - (size_t)dd * NIN); }
}
template <int WIN>
__device__ __forceinline__ void z_fin(const v4u (&w)[WIN], bf16* Z, int tp, int g, int lane) {
    const int t = 2 * tp + (lane >> 5), c8 = g * PG + (lane & 31) * 8, pos = t & (SEQ - 1);
    float s[8];
#pragma unroll
    for (int j = 0; j < 8; ++j) s[j] = 0.f;
#pragma unroll
    for (int d = 0; d < WIN; ++d) { const float m = (d <= pos) ? 1.f : 0.f;
        s[0] += m * bflo(w[d].x); s[1] += m * bfhi(w[d].x); s[2] += m * bflo(w[d].y); s[3] += m * bfhi(w[d].y); s[4] += m * bflo(w[d].z); s[5] += m * bfhi(w[d].z); s[6] += m * bflo(w[d].w); s[7] += m * bfhi(w[d].w); }
    const int cnt = (pos + 1 < WIN) ? pos + 1 : WIN; const float inv = 1.0f / (float)cnt; v4u o;
    o.x = pk2(s[0] * inv - bflo(w[0].x), s[1] * inv - bfhi(w[0].x)); o.y = pk2(s[2] * inv - bflo(w[0].y), s[3] * inv - bfhi(w[0].y));
    o.z = pk2(s[4] * inv - bflo(w[0].z), s[5] * inv - bfhi(w[0].z)); o.w = pk2(s[6] * inv - bflo(w[0].w), s[7] * inv - bfhi(w[0].w));
    *(GAS v4u*)(Z + (size_t)t * PW + c8) = o;
}
__device__ __forceinline__ void p2_kmean_z(Frame& F) {
    const bf16* proj = WSP(bf16, WS_PROJ); float* kmean = WSP(float, WS_KMEAN);
    LAS float* scr = (LAS float*)F.lds;
    for (int it = F.vcu; it < BATCH * NBLK * NH; it += F.G) {
        const int h = it & 7, blk = (it >> 3) & 31, b = it >> 8;
        const GAS unsigned* src = (const GAS unsigned*)(proj + ((size_t)(b * SEQ + blk * MBLK + F.wave * 32)) * NIN + AW + h * HD) + F.lane;
        float s0 = 0.f, s1 = 0.f;
#pragma unroll
        for (int r = 0; r < 32; ++r) { const unsigned w = src[(size_t)r * (NIN / 2)]; s0 += bflo(w); s1 += bfhi(w); }
        __syncthreads();
        scr[F.wave * 128 + 2 * F.lane] = s0; scr[F.wave * 128 + 2 * F.lane + 1] = s1;
        __syncthreads();
        if (F.tid < 128) { float s = 0.f;
#pragma unroll
            for (int w = 0; w < 8; ++w) s += scr[w * 128 + F.tid];
            kmean[((size_t)(b * NH + h) * NBLK + blk) * HD + F.tid] = s * (1.f / MBLK); }
    }
    __syncthreads();
    const int gw = F.vcu * NWAVES + F.wave, NGW = F.G * NWAVES;
    bf16* Z = WSP(bf16, WS_Z);
    for (int tp = gw; tp < T / 2; tp += NGW) {
        v4u w2[2], w4[4], w8[8], w16[16];
        z_load<2>(proj, tp, 0, F.lane, w2); z_load<4>(proj, tp, 1, F.lane, w4); z_load<8>(proj, tp, 2, F.lane, w8); z_load<16>(proj, tp, 3, F.lane, w16);
        z_fin<2>(w2, Z, tp, 0, F.lane); z_fin<4>(w4, Z, tp, 1, F.lane); z_fin<8>(w8, Z, tp, 2, F.lane); z_fin<16>(w16, Z, tp, 3, F.lane);
    }
}

__device__ __forceinline__ float dot_row(const bf16* krow, const unsigned (&qp)[64]) {
    const GAS v4u* k4 = (const GAS v4u*)krow; float a0 = 0.f, a1 = 0.f;
#pragma unroll
    for (int c = 0; c < 16; ++c) { const v4u w = k4[c];
        a0 += bflo(w.x) * bflo(qp[4 * c]) + bflo(w.y) * bflo(qp[4 * c + 1]) + bflo(w.z) * bflo(qp[4 * c + 2]) + bflo(w.w) * bflo(qp[4 * c + 3]);
        a1 += bfhi(w.x) * bfhi(qp[4 * c]) + bfhi(w.y) * bfhi(qp[4 * c + 1]) + bfhi(w.z) * bfhi(qp[4 * c + 2]) + bfhi(w.w) * bfhi(qp[4 * c + 3]); }
    return a0 + a1;
}
__device__ __forceinline__ void attn_simple(Frame& F) {
    const bf16* proj = WSP(bf16, WS_PROJ); const float* kmean = WSP(float, WS_KMEAN); bf16* MIXB = WSP(bf16, WS_MIX);
    LAS unsigned* qs = (LAS unsigned*)(F.lds + F.wave * 256);
    const int gw = F.vcu * NWAVES + F.wave, NGW = F.G * NWAVES, lane = F.lane;
    const float scale = 0.08838834764831845f;
    for (int item = gw; item < T * NH; item += NGW) {
        const int h = item & 7, t = item >> 3, b = t >> 13, qpos = t & (SEQ - 1), own = qpos >> 8;
        const float slope = __builtin_bit_cast(float, (unsigned)(127 - (h + 1)) << 23);
        qs[lane] = ((const GAS unsigned*)(proj + (size_t)t * NIN + h * HD))[lane];
        LDS_WAIT();
        unsigned qp[64];
#pragma unroll
        for (int c = 0; c < 16; ++c) { const v4u w = *(const LAS v4u*)(qs + 4 * c); qp[4 * c] = w.x; qp[4 * c + 1] = w.y; qp[4 * c + 2] = w.z; qp[4 * c + 3] = w.w; }
        LDS_WAIT();
        float gate = -INFINITY;
        if (lane < own) { const GAS f32x4* km = (const GAS f32x4*)(kmean + ((size_t)(b * NH + h) * NBLK + lane) * HD); float a = 0.f;
#pragma unroll
            for (int c = 0; c < 32; ++c) { const f32x4 kv = km[c]; a += kv.x * bflo(qp[2 * c]) + kv.y * bfhi(qp[2 * c]) + kv.z * bflo(qp[2 * c + 1]) + kv.w * bfhi(qp[2 * c + 1]); }
            gate = a; }
        int sel[3] = {0, 0, 0};
#pragma unroll
        for (int r = 0; r < 3; ++r) if (r < own) { const float m = wave_max(gate); const unsigned long long bal = __ballot(gate == m); const int s = __ffsll((long long)bal) - 1; sel[r] = s; if (lane == s) gate = -INFINITY; }
        float sc[4][4];
#pragma unroll
        for (int s = 0; s < 4; ++s) { const bool valid = (s == 3) || (s < own); const int blk = (s == 3) ? own : sel[s];
#pragma unroll
            for (int i = 0; i < 4; ++i) { const int kpos = blk * MBLK + lane + 64 * i; float v = -INFINITY;
                if (valid) { const float d = dot_row(proj + (size_t)(b * SEQ + kpos) * NIN + AW + h * HD, qp); v = d * scale - slope * (float)(qpos - kpos); if (s == 3 && kpos > qpos) v = -INFINITY; }
                sc[s][i] = v; } }
        float mx = -INFINITY;
#pragma unroll
        for (int s = 0; s < 4; ++s)
#pragma unroll
            for (int i = 0; i < 4; ++i) mx = fmaxf(mx, sc[s][i]);
        mx = wave_max(mx);
        float ls = 0.f;
#pragma unroll
        for (int s = 0; s < 4; ++s)
#pragma unroll
            for (int i = 0; i < 4; ++i) { sc[s][i] = __expf(sc[s][i] - mx); ls += sc[s][i]; }
        ls = wave_sum(ls);
        float o0 = 0.f, o1 = 0.f;
#pragma unroll
        for (int s = 0; s < 4; ++s) { const bool valid = (s == 3) || (s < own); const int blk = (s == 3) ? own : sel[s];
            if (valid) {
#pragma unroll
                for (int i = 0; i < 4; ++i) { const GAS unsigned* vb = (const GAS unsigned*)(proj + (size_t)(b * SEQ + blk * MBLK + 64 * i) * NIN + 2 * AW + h * HD) + lane;
#pragma unroll 8
                    for (int kk = 0; kk < 64; ++kk) { const float pk = __builtin_bit_cast(float, __builtin_amdgcn_readlane(__builtin_bit_cast(int, sc[s][i]), kk));
                        const unsigned w = vb[(size_t)kk * (NIN / 2)]; o0 += pk * bflo(w); o1 += pk * bfhi(w); } } } }
        const float il = 1.0f / ls;
        ((GAS unsigned*)(MIXB + (size_t)t * DM + h * HD))[lane] = pk2(o0 * il, o1 * il);
    }
}

__device__ __forceinline__ void p4_mix_norm(Frame& F) {
    bf16* MIXB = WSP(bf16, WS_MIX); const bf16* OP = (const bf16*)F.out; const float* ML = (const float*)(F.ws + (1052u << 20));
    const int gw = F.vcu * NWAVES + F.wave, NGW = F.G * NWAVES, lane = F.lane, h = lane >> 3, sub = lane & 7;
    float gbv[16]; { const float* gb = F.beta_attn + h * HD + 4 * sub;
#pragma unroll
      for (int i = 0; i < 16; ++i) gbv[i] = gb[32 * (i & 3) + (i >> 2)]; }
    f32x4 gpv[4];
#pragma unroll
    for (int j = 0; j < 2; ++j) { const float* gp = F.pool_scale + (64 * j + lane) * 8; gpv[2 * j] = *(const GAS f32x4*)gp; gpv[2 * j + 1] = *(const GAS f32x4*)(gp + 4); }
    v4u pa[4][2], npa[4][2]; f32x4 ml0, ml1, nml0, nml1; v4u pw0, pw1, npw0, npw1;
#define MIX_LOAD(mm, PA, M0, M1, W0, W1) do { const size_t rec_ = (size_t)(mm) * NH + h; \
        _Pragma("unroll") for (int k = 0; k < 4; ++k) { const GAS v4u* src = (const GAS v4u*)(OP + (rec_ * 4 + k) * HD + sub * 16); PA[k][0] = __builtin_nontemporal_load(src); PA[k][1] = __builtin_nontemporal_load(src + 1); }     \
        const GAS f32x4* mlp = (const GAS f32x4*)(ML + rec_ * 8); M0 = __builtin_nontemporal_load(mlp); M1 = __builtin_nontemporal_load(mlp + 1);         \
        const GAS v4u* pr_ = (const GAS v4u*)(MIXB + (size_t)(mm) * DM + AW) + lane; W0 = pr_[0]; W1 = pr_[64]; } while (0)
    MIX_LOAD(gw, pa, ml0, ml1, pw0, pw1); VM_WAIT();
    for (int m = gw; m < T; m += NGW) {
        const int blk = (m & (SEQ - 1)) >> 8, nv = blk < 3 ? blk : 3;
        { const int mn = (m + NGW < T) ? m + NGW : m; MIX_LOAD(mn, npa, nml0, nml1, npw0, npw1); }
        GAS v4u* prow = (GAS v4u*)(MIXB + (size_t)m * DM + AW) + lane;
        const float mk[4] = {nv > 0 ? ml0.x : -1e30f, nv > 1 ? ml0.z : -1e30f, nv > 2 ? ml1.x : -1e30f, ml1.z};
        const float lk[4] = {nv > 0 ? ml0.y : 0.f, nv > 1 ? ml0.w : 0.f, nv > 2 ? ml1.y : 0.f, ml1.w};
        const float M = fmaxf(fmaxf(mk[0], mk[1]), fmaxf(mk[2], mk[3]));
        float e[4]; float L = 0.f;
#pragma unroll
        for (int k = 0; k < 4; ++k) { e[k] = lk[k] * __builtin_amdgcn_exp2f(mk[k] - M); L += e[k]; }
        const float iL = 1.0f / L;
        float f[16];
#pragma unroll
        for (int i = 0; i < 16; ++i) f[i] = 0.f;
#pragma unroll
        for (int k = 0; k < 4; ++k) { const bool ok = (k == 3) || (k < nv); const float w = e[k] * iL;
#pragma unroll
            for (int q = 0; q < 2; ++q) { const v4u x = pa[k][q]; const unsigned x0 = ok ? x.x : 0u, x1 = ok ? x.y : 0u, x2 = ok ? x.z : 0u, x3 = ok ? x.w : 0u;
                f[8 * q + 0] += w * bflo(x0); f[8 * q + 1] += w * bfhi(x0); f[8 * q + 2] += w * bflo(x1); f[8 * q + 3] += w * bfhi(x1);
                f[8 * q + 4] += w * bflo(x2); f[8 * q + 5] += w * bfhi(x2); f[8 * q + 6] += w * bflo(x3); f[8 * q + 7] += w * bfhi(x3); } }
        float ssa = 0.f;
#pragma unroll
        for (int i = 0; i < 16; ++i) { f[i] = bflo(f2bf(f[i]) ); ssa += f[i] * f[i]; }
        float pf[2][8]; float ssp = 0.f;
        { const v4u w[2] = {pw0, pw1};
#pragma unroll
          for (int j = 0; j < 2; ++j) { pf[j][0] = bflo(w[j].x); pf[j][1] = bfhi(w[j].x); pf[j][2] = bflo(w[j].y); pf[j][3] = bfhi(w[j].y); pf[j][4] = bflo(w[j].z); pf[j][5] = bfhi(w[j].z); pf[j][6] = bflo(w[j].w); pf[j][7] = bfhi(w[j].w);
#pragma unroll
              for (int k = 0; k < 8; ++k) ssp += pf[j][k] * pf[j][k]; } }
        ssa = wave_sum(ssa); ssp = wave_sum(ssp);
        const float ra = 1.0f / sqrtf(ssa * (1.f / AW) + EPS), rp = 1.0f / sqrtf(ssp * (1.f / PW) + EPS);
        { float o[16];
#pragma unroll
          for (int i = 0; i < 16; ++i) o[i] = f[i] * ra * gbv[i];
          GAS v4u* dst = (GAS v4u*)(MIXB + (size_t)m * DM + h * HD + sub * 16); v4u o0, o1;
          o0.x = pk2(o[0], o[1]); o0.y = pk2(o[2], o[3]); o0.z = pk2(o[4], o[5]); o0.w = pk2(o[6], o[7]); o1.x = pk2(o[8], o[9]); o1.y = pk2(o[10], o[11]); o1.z = pk2(o[12], o[13]); o1.w = pk2(o[14], o[15]);
          dst[0] = o0; dst[1] = o1; }
#pragma unroll
        for (int j = 0; j < 2; ++j) { const f32x4 g0 = gpv[2 * j], g1 = gpv[2 * j + 1]; v4u o;
            o.x = pk2(pf[j][0] * rp * g0.x, pf[j][1] * rp * g0.y); o.y = pk2(pf[j][2] * rp * g0.z, pf[j][3] * rp * g0.w);
            o.z = pk2(pf[j][4] * rp * g1.x, pf[j][5] * rp * g1.y); o.w = pk2(pf[j][6] * rp * g1.z, pf[j][7] * rp * g1.w);
            prow[64 * j] = o; }
#pragma unroll
        for (int k = 0; k < 4; ++k) { pa[k][0] = npa[k][0]; pa[k][1] = npa[k][1]; }
        ml0 = nml0; ml1 = nml1; pw0 = npw0; pw1 = npw1;
    }
#undef MIX_LOAD
}

__device__ __forceinline__ void gain_load(const float* gain, int lane, f32x4 (&g)[8]) {
#pragma unroll
    for (int j = 0; j < 4; ++j) { const GAS f32x4* g4 = (const GAS f32x4*)(gain + (64 * j + lane) * 8); g[2 * j] = g4[0]; g[2 * j + 1] = g4[1]; }
}
__device__ __forceinline__ void row_norm_bf_store_g(const float (&f)[4][8], float ss, const f32x4 (&g)[8], bf16* orow, int lane) {
    const float r = 1.0f / sqrtf(ss * (1.f / DM) + EPS);
    GAS v4u* o4 = (GAS v4u*)orow + lane;
#pragma unroll
    for (int j = 0; j < 4; ++j) { const f32x4 g0 = g[2 * j], g1 = g[2 * j + 1]; v4u o;
        o.x = pk2(f[j][0] * r * g0.x, f[j][1] * r * g0.y); o.y = pk2(f[j][2] * r * g0.z, f[j][3] * r * g0.w);
        o.z = pk2(f[j][4] * r * g1.x, f[j][5] * r * g1.y); o.w = pk2(f[j][6] * r * g1.z, f[j][7] * r * g1.w); o4[64 * j] = o; }
}
__device__ __forceinline__ void p6_norm_f(Frame& F) {
    const int gw = F.vcu * NWAVES + F.wave, NGW = F.G * NWAVES; const bf16* HB = (const bf16*)F.out; float* rsf = WSP(float, WS_RSF);
    v4u cur[4]; row_ldp(HB + (size_t)gw * DM, F.lane, cur); VM_WAIT();
    for (int m = gw; m < T; m += NGW) { const int mn = (m + NGW < T) ? m + NGW : m; v4u nx[4]; row_ldp(HB + (size_t)mn * DM, F.lane, nx);
        float f[4][8]; row_unpack(cur, f); const float ss = row_ss_bf(f); if (F.lane == 0) rsf[m] = 1.0f / sqrtf(ss * (1.f / DM) + EPS);
#pragma unroll
        for (int j = 0; j < 4; ++j) cur[j] = nx[j]; }
}

__device__ __forceinline__ void p8_route(Frame& F) {
    const float* LG = WSP(float, WS_LOGIT); int* elist = (int*)(F.ws + WS_ROUTE + RT_ELIST); float* ewl = (float*)(F.ws + WS_ROUTE + RT_EWL);
    LAS unsigned* hist = (LAS unsigned*)(F.lds); LAS unsigned* ebase = hist + 64;
    constexpr int CH = NWAVES * 64;
    for (int c0 = F.vcu * CH; c0 < T; c0 += F.G * CH) {
        __syncthreads();
        if (F.tid < 64) hist[F.tid] = 0u;
        __syncthreads();
        const int t = c0 + F.tid;
        const float* l = LG + (size_t)t * 128; const float* l2 = l + (size_t)T * 128;
        float rs; { const float* sq = WSP(float, WS_SSQ) + t; float a0 = 0.f, a1 = 0.f, a2 = 0.f, a3 = 0.f;
#pragma unroll
          for (int k = 0; k < 32; k += 4) { a0 += sq[(size_t)k * T]; a1 += sq[(size_t)(k + 1) * T]; a2 += sq[(size_t)(k + 2) * T]; a3 += sq[(size_t)(k + 3) * T]; }
          rs = 1.0f / sqrtf(((a0 + a1) + (a2 + a3)) * (1.f / DM) + EPS); }
        float lg[8]; float gm = -INFINITY; int gi = 0;
#pragma unroll
        for (int j = 0; j < 8; ++j) { lg[j] = (l[j] + l2[j]) * rs + F.b_rg[j]; if (lg[j] > gm) { gm = lg[j]; gi = j; } }
        float gs = 0.f;
#pragma unroll
        for (int j = 0; j < 8; ++j) gs += __expf(lg[j] - gm);
        const float gval = 1.0f / gs;
        float le[8]; float em = -INFINITY;
#pragma unroll
        for (int j = 0; j < 8; ++j) { le[j] = (l[8 + gi * 8 + j] + l2[8 + gi * 8 + j]) * rs + F.b_re[gi * 8 + j]; em = fmaxf(em, le[j]); }
        float es = 0.f;
#pragma unroll
        for (int j = 0; j < 8; ++j) { le[j] = __expf(le[j] - em); es += le[j]; }
        float v1 = -1.f, v2 = -1.f; int i1 = 0, i2 = 0;
#pragma unroll
        for (int j = 0; j < 8; ++j) { const float pv = le[j] / es; if (pv > v1) { v2 = v1; i2 = i1; v1 = pv; i1 = j; } else if (pv > v2) { v2 = pv; i2 = j; } }
        const float inv = 1.0f / (v1 + v2);
        const int e1 = gi * 8 + i1, e2 = gi * 8 + i2;
        const unsigned r1 = __hip_atomic_fetch_add(hist + e1, 1u, __ATOMIC_RELAXED, __HIP_MEMORY_SCOPE_WORKGROUP), r2 = __hip_atomic_fetch_add(hist + e2, 1u, __ATOMIC_RELAXED, __HIP_MEMORY_SCOPE_WORKGROUP);
        __syncthreads();
        if (F.tid < 64) { const unsigned c = hist[F.tid]; ebase[F.tid] = c ? atomicAdd((unsigned*)(F.ctl + CW_ECNT + F.tid), c) : 0u; }
        __syncthreads();
        const int k1 = (int)(ebase[e1] + r1), k2 = (int)(ebase[e2] + r2);
        elist[e1 * T + k1] = 2 * t; ewl[e1 * T + k1] = gval * (v1 * inv); elist[e2 * T + k2] = 2 * t + 1; ewl[e2 * T + k2] = gval * (v2 * inv);
        { float* ers = WSP(float, WS_ERS); ers[e1 * T + k1] = rs; ers[e2 * T + k2] = rs; }
    }
    __syncthreads();
}
__device__ __forceinline__ void p12_combine(Frame& F) {
    const bf16* Y = WSP(bf16, WS_PROJ); bf16* HB = (bf16*)F.out;
    const int gw = F.vcu * NWAVES + F.wave, NGW = F.G * NWAVES, lane = F.lane;
    v4u cf[4], c0[4], c1[4]; row_ldp_nt(HB + (size_t)gw * DM, lane, cf); row_ldp_nt(Y + (size_t)(2 * gw) * DM, lane, c0); row_ldp_nt(Y + (size_t)(2 * gw + 1) * DM, lane, c1); VM_WAIT();
    for (int m = gw; m < T; m += NGW) { const int mn = (m + NGW < T) ? m + NGW : m; bf16* hrow = HB + (size_t)m * DM;
        v4u nf[4], n0[4], n1[4]; row_ldp_nt(HB + (size_t)mn * DM, lane, nf); row_ldp_nt(Y + (size_t)(2 * mn) * DM, lane, n0); row_ldp_nt(Y + (size_t)(2 * mn + 1) * DM, lane, n1);
        float f[4][8], y0[4][8], y1[4][8]; row_unpack(cf, f); row_unpack(c0, y0); row_unpack(c1, y1);
        GAS v4u* o4 = (GAS v4u*)hrow + lane;
#pragma unroll
        for (int j = 0; j < 4; ++j) {
#pragma unroll
            for (int k = 0; k < 8; ++k) f[j][k] += y0[j][k] + y1[j][k];
            v4u o; o.x = pk2(f[j][0], f[j][1]); o.y = pk2(f[j][2], f[j][3]); o.z = pk2(f[j][4], f[j][5]); o.w = pk2(f[j][6], f[j][7]); o4[64 * j] = o; }
        const float ss = row_ss_bf(f); if (lane == 0) WSP(float, WS_RS3)[m] = 1.0f / sqrtf(ss * (1.f / DM) + EPS);
#pragma unroll
        for (int j = 0; j < 4; ++j) { cf[j] = nf[j]; c0[j] = n0[j]; c1[j] = n1[j]; } }
}
__device__ __forceinline__ void p15_final(Frame& F) {
    const bf16* H3 = WSP(bf16, WS_PROJ);
    const int gw = F.vcu * NWAVES + F.wave, NGW = F.G * NWAVES, lane = F.lane;
    f32x4 gn[8]; gain_load(F.g_final, lane, gn);
    v4u cur[4]; row_ldp_nt(H3 + (size_t)gw * DM, lane, cur); VM_WAIT();
    for (int m = gw; m < T; m += NGW) { const int mn = (m + NGW < T) ? m + NGW : m; v4u nx[4]; row_ldp_nt(H3 + (size_t)mn * DM, lane, nx); float f[4][8]; row_unpack(cur, f); const float ss = row_ss_bf(f);
        const float r = 1.0f / sqrtf(ss * (1.f / DM) + EPS); float* orow = F.out + (size_t)m * DM;
#pragma unroll
        for (int j = 0; j < 4; ++j) { const int col = (64 * j + lane) * 8; const f32x4 g0 = gn[2 * j], g1 = gn[2 * j + 1];
            f32x4 o0, o1; o0.x = f[j][0] * r * g0.x; o0.y = f[j][1] * r * g0.y; o0.z = f[j][2] * r * g0.z; o0.w = f[j][3] * r * g0.w;
            o1.x = f[j][4] * r * g1.x; o1.y = f[j][5] * r * g1.y; o1.z = f[j][6] * r * g1.z; o1.w = f[j][7] * r * g1.w;
            __builtin_nontemporal_store(o0, (GAS f32x4*)(orow + col)); __builtin_nontemporal_store(o1, (GAS f32x4*)(orow + col + 4)); }
#pragma unroll
        for (int j = 0; j < 4; ++j) cur[j] = nx[j]; }
}

constexpr int CW_ACNT = 32768;
constexpr int LISTCAP = SEQ * 31 - MBLK * (31 * 32 / 2);
__host__ __device__ constexpr int list_base(int j) { return SEQ * j - MBLK * (j * (j + 1) / 2); }
constexpr size_t WS_ALIST = 1035 * MiB;
constexpr size_t WS_ML = 1052 * MiB;
constexpr size_t WS_END2 = 1097 * MiB;
constexpr int ATAB_OFF = TAB_OFF;

namespace att {
using bf16x8 = __attribute__((ext_vector_type(8))) short;
using s16x4  = __attribute__((ext_vector_type(4))) short;
using f32x16 = __attribute__((ext_vector_type(16))) float;
using u32x4  = __attribute__((ext_vector_type(4))) unsigned;
constexpr int D = 128, NW = 8, QBLK = 32, KVBLK = 64, LDK = NIN;
constexpr float SCALE = 0.088388347648318440f;
constexpr float THR = 8.f;
constexpr float C = SCALE * 1.4426950408889634f;
constexpr size_t SHM_V = KVBLK * D * 2, SHM_K = KVBLK * D * 2;
constexpr int WS_OFF = 2 * SHM_V + 2 * SHM_K;
#define KSWZ(row, colB) ((row) * 256 + ((colB) ^ (((row) & 7) << 4)))
#define SBAR() __builtin_amdgcn_sched_barrier(0)
__device__ __forceinline__ int crow(int r, int hi) { return (r & 3) + 8 * (r >> 2) + 4 * hi; }
__device__ __forceinline__ unsigned cvtpk(float lo, float hi) { unsigned r; asm volatile("v_cvt_pk_bf16_f32 %0, %1, %2" : "=v"(r) : "v"(lo), "v"(hi)); return r; }

__device__ __forceinline__ void partialSM(f32x16& p0, f32x16& p1, float& m_reg, float& mn, float& alpha) {
  float pmax = p0[0];
#pragma unroll
  for (int r = 1; r < 16; ++r) pmax = fmaxf(pmax, p0[r]);
#pragma unroll
  for (int r = 0; r < 16; ++r) pmax = fmaxf(pmax, p1[r]);
  { auto rr = __builtin_amdgcn_permlane32_swap(__float_as_uint(pmax), __float_as_uint(pmax), false, false);
    pmax = fmaxf(__uint_as_float(rr[0]), __uint_as_float(rr[1])); }
  { const bool keep = (pmax - m_reg <= THR / SCALE); mn = keep ? m_reg : pmax; alpha = keep ? 1.f : __builtin_amdgcn_exp2f((m_reg - mn) * C); m_reg = mn; }
  float mnC = -mn * C;
#pragma unroll
  for (int r = 0; r < 16; ++r) p0[r] = fmaf(p0[r], C, mnC);
#pragma unroll
  for (int r = 0; r < 16; ++r) p1[r] = fmaf(p1[r], C, mnC);
#pragma unroll
  for (int r = 0; r < 16; ++r) p0[r] = __builtin_amdgcn_exp2f(p0[r]);
}
__device__ __forceinline__ void finishSM(f32x16& p0, f32x16& p1, float alpha, float& l_reg, bf16x8& pa0, bf16x8& pa1, bf16x8& pa2, bf16x8& pa3) {
#pragma unroll
  for (int r = 0; r < 16; ++r) p1[r] = __builtin_amdgcn_exp2f(p1[r]);
  float ps = 0;
#pragma unroll
  for (int r = 0; r < 16; ++r) ps += p0[r];
#pragma unroll
  for (int r = 0; r < 16; ++r) ps += p1[r];
  { auto rr = __builtin_amdgcn_permlane32_swap(__float_as_uint(ps), __float_as_uint(ps), false, false);
    ps = __uint_as_float(rr[0]) + __uint_as_float(rr[1]); }
  l_reg = l_reg * alpha + ps;
#define PK4(P, BASE, OUT) do { unsigned a0 = cvtpk(P[BASE + 0], P[BASE + 1]), a1 = cvtpk(P[BASE + 2], P[BASE + 3]);   \
    unsigned b0 = cvtpk(P[BASE + 4], P[BASE + 5]), b1 = cvtpk(P[BASE + 6], P[BASE + 7]);                              \
    auto r0 = __builtin_amdgcn_permlane32_swap(a0, b0, false, false); auto r1 = __builtin_amdgcn_permlane32_swap(a1, b1, false, false); \
    u32x4 w = {r0[0], r1[0], r0[1], r1[1]}; OUT = *reinterpret_cast<bf16x8*>(&w); } while (0)
  PK4(p0, 0, pa0); PK4(p0, 8, pa1); PK4(p1, 0, pa2); PK4(p1, 8, pa3);
#undef PK4
}
template <bool OWN>
__device__ __forceinline__ void qkt(f32x16& p0, f32x16& p1, const char* Ks, const bf16x8* qr, int r32, int hi, float ks, float kbase, int qrel) {
#pragma unroll
  for (int r = 0; r < 16; ++r) { p0[r] = fmaf(ks, (float)((r & 3) + 8 * (r >> 2)), kbase); p1[r] = fmaf(ks, (float)(32 + (r & 3) + 8 * (r >> 2)), kbase); }
#pragma unroll
  for (int d0 = 0; d0 < 8; ++d0) { int cb = (d0 * 16 + hi * 8) * 2;
    bf16x8 b0 = *reinterpret_cast<const bf16x8*>(Ks + KSWZ(r32, cb));
    bf16x8 b1 = *reinterpret_cast<const bf16x8*>(Ks + KSWZ(32 + r32, cb));
    p0 = __builtin_amdgcn_mfma_f32_32x32x16_bf16(b0, qr[d0], p0, 0, 0, 0);
    p1 = __builtin_amdgcn_mfma_f32_32x32x16_bf16(b1, qr[d0], p1, 0, 0, 0); }
  if constexpr (OWN) {
#pragma unroll
    for (int r = 0; r < 16; ++r) { if (((r & 3) + 8 * (r >> 2)) > qrel) p0[r] = -1e30f; if ((32 + (r & 3) + 8 * (r >> 2)) > qrel) p1[r] = -1e30f; }
  }
}
__device__ __forceinline__ int v_st(int k, int c) { const int kk = (k & ~0xC) | ((k & 4) << 1) | ((k & 8) >> 1); return ((kk >> 3) * 4 + (c >> 5)) * 512 + ((kk & 7) * 32 + (c & 31)) * 2; }
__device__ __forceinline__ int v_rd_base(int lane) { return ((lane & 3) << 3) | (((lane >> 2) & 3) << 6) | (((lane >> 4) & 1) << 5) | (((lane >> 5) & 1) << 8); }
constexpr int v_rd_off(int d0, int ks, int half) { return d0 * 512 + ks * 4096 + half * 2048; }
template <int OFF> __device__ __forceinline__ s16x4 tr_read(int vb) {
  s16x4 r; asm volatile("ds_read_b64_tr_b16 %0, %1 offset:%2" : "=&v"(r) : "v"(vb), "i"(OFF) : "memory"); return r;
}
template <int D0> __device__ __forceinline__ void pv_one(f32x16& od, int vb, bf16x8 pa0, bf16x8 pa1, bf16x8 pa2, bf16x8 pa3) {
  const s16x4 l0 = tr_read<v_rd_off(D0, 0, 0)>(vb), h0 = tr_read<v_rd_off(D0, 0, 1)>(vb), l1 = tr_read<v_rd_off(D0, 1, 0)>(vb), h1 = tr_read<v_rd_off(D0, 1, 1)>(vb);
  const s16x4 l2 = tr_read<v_rd_off(D0, 2, 0)>(vb), h2 = tr_read<v_rd_off(D0, 2, 1)>(vb), l3 = tr_read<v_rd_off(D0, 3, 0)>(vb), h3 = tr_read<v_rd_off(D0, 3, 1)>(vb);
  asm volatile("s_waitcnt lgkmcnt(0)" ::: "memory"); SBAR();
#define PK(L, H) (bf16x8){L[0], L[1], L[2], L[3], H[0], H[1], H[2], H[3]}
  od = __builtin_amdgcn_mfma_f32_32x32x16_bf16(pa0, PK(l0, h0), od, 0, 0, 0);
  od = __builtin_amdgcn_mfma_f32_32x32x16_bf16(pa1, PK(l1, h1), od, 0, 0, 0);
  od = __builtin_amdgcn_mfma_f32_32x32x16_bf16(pa2, PK(l2, h2), od, 0, 0, 0);
  od = __builtin_amdgcn_mfma_f32_32x32x16_bf16(pa3, PK(l3, h3), od, 0, 0, 0);
#undef PK
}
__device__ __forceinline__ void pv_d0(f32x16* o, int vb, bf16x8 pa0, bf16x8 pa1, bf16x8 pa2, bf16x8 pa3) {
  pv_one<0>(o[0], vb, pa0, pa1, pa2, pa3); pv_one<1>(o[1], vb, pa0, pa1, pa2, pa3); pv_one<2>(o[2], vb, pa0, pa1, pa2, pa3); pv_one<3>(o[3], vb, pa0, pa1, pa2, pa3);
}

constexpr int KV_K_OFF = 0, KV_V_OFF = 65536, WSCR_OFF = 147456;
__device__ __forceinline__ void kv_load_block(const bf16* __restrict__ proj, int b, int h, int blk, char* lds) {
  const int tid = threadIdx.x, sr = tid >> 4, sc = (tid & 15) * 8;
  const bf16* Kh = proj + ((size_t)b * SEQ + (size_t)blk * MBLK) * NIN + AW + h * HD;
  const bf16* Vh = Kh + AW;
  bf16x8 kr[8], vr[8];
#pragma unroll
  for (int i = 0; i < 8; ++i) { kr[i] = *reinterpret_cast<const bf16x8*>(&Kh[(size_t)(sr + 32 * i) * LDK + sc]); vr[i] = *reinterpret_cast<const bf16x8*>(&Vh[(size_t)(sr + 32 * i) * LDK + sc]); }
  __syncthreads();
#pragma unroll
  for (int i = 0; i < 8; ++i) { const int row = sr + 32 * i, kt = row >> 6, r = row & 63;
    *(bf16x8*)(lds + KV_K_OFF + kt * 16384 + KSWZ(r, sc * 2)) = kr[i];
    *(bf16x8*)(lds + KV_V_OFF + kt * 16384 + v_st(r, sc)) = vr[i]; }
  __syncthreads();
}
__device__ __forceinline__ void ld_q(const bf16* __restrict__ proj, int b, int h, int qpos, int hi, bf16x8 (&qr)[8]) {
  const bf16* Qw = proj + ((size_t)b * SEQ + qpos) * NIN + h * HD + hi * 8;
#pragma unroll
  for (int d0 = 0; d0 < 8; ++d0) qr[d0] = *reinterpret_cast<const bf16x8*>(Qw + d0 * 16);
}
template <bool OWN, int NT>
__device__ __forceinline__ void wave_group(int b, int h, int blk, int g, int qpos, int rank, bool valid, const bf16x8 (&qr)[8],
                                           bf16* __restrict__ OP, float* __restrict__ ML, char* lds) {
  const int tid = threadIdx.x, wid = tid >> 6; int lane = tid & 63;
  asm volatile("" : "+v"(lane));
  const int r32 = lane & 31, hi = lane >> 5;
  const char* K_lds = lds + KV_K_OFF;
  float* ws = (float*)(lds + WSCR_OFF) + wid * 256;
  float* li_l = ws; float* al_l = ws + 32; int* dst_l = (int*)(ws + 128);
  const float slope = __builtin_bit_cast(float, (unsigned)(127 - (h + 1)) << 23);
  const float ks = slope * (1.0f / SCALE);
  const int qi = g * QBLK + r32;
  const size_t tok = (size_t)b * SEQ + qpos;
  float m_reg = -1e30f, l_reg = 0; f32x16 o[4] = {};
  const int vb0 = (int)(uintptr_t)(lds + KV_V_OFF) + v_rd_base(lane);
#define RESC(a) do { if (__any((a) < 1.f)) { if (hi == 0) al_l[r32] = (a); asm volatile("s_waitcnt lgkmcnt(0)" ::: "memory"); \
    _Pragma("unroll") for (int d = 0; d < 4; ++d) _Pragma("unroll") for (int r = 0; r < 16; ++r) o[d][r] *= al_l[crow(r, hi)]; } } while (0)
#define KBASE(kt) (ks * (float)((kt) * 64 + 4 * hi))
#define QREL(kt) (qi - 64 * (kt) - 4 * hi)
  bf16x8 pa0, pa1, pa2, pa3;
  {
    f32x16 pA0, pA1, pB0, pB1; float mnA, mnB, alA, alB;
#define QK(P0, P1, t) qkt<OWN>(P0, P1, K_lds + (t) * 16384, qr, r32, hi, ks, KBASE(t), QREL(t))
#define PV(t) pv_d0(o, vb0 + (t) * 16384, pa0, pa1, pa2, pa3)
    QK(pA0, pA1, NT - 1); partialSM(pA0, pA1, m_reg, mnA, alA);
    if constexpr (NT >= 2) {
      SBAR(); QK(pB0, pB1, NT - 2); finishSM(pA0, pA1, alA, l_reg, pa0, pa1, pa2, pa3); SBAR(); PV(NT - 1); partialSM(pB0, pB1, m_reg, mnB, alB); RESC(alB);
      if constexpr (NT >= 3) {
        SBAR(); QK(pA0, pA1, NT - 3); finishSM(pB0, pB1, alB, l_reg, pa0, pa1, pa2, pa3); SBAR(); PV(NT - 2); partialSM(pA0, pA1, m_reg, mnA, alA); RESC(alA);
        if constexpr (NT >= 4) {
          SBAR(); QK(pB0, pB1, NT - 4); finishSM(pA0, pA1, alA, l_reg, pa0, pa1, pa2, pa3); SBAR(); PV(NT - 3); partialSM(pB0, pB1, m_reg, mnB, alB); RESC(alB);
          finishSM(pB0, pB1, alB, l_reg, pa0, pa1, pa2, pa3); SBAR(); PV(0);
        } else { finishSM(pA0, pA1, alA, l_reg, pa0, pa1, pa2, pa3); SBAR(); PV(0); }
      } else { finishSM(pB0, pB1, alB, l_reg, pa0, pa1, pa2, pa3); SBAR(); PV(0); }
    } else { finishSM(pA0, pA1, alA, l_reg, pa0, pa1, pa2, pa3); SBAR(); PV(0); }
#undef QK
#undef PV
  }
  const float mlog = m_reg * C + 1.4426950408889634f * slope * (float)(blk * MBLK - qpos);
  {
    const int dst = valid ? (int)((tok * NH + h) * 4 + (OWN ? 3 : rank)) : -1;
    if (hi == 0) { li_l[r32] = l_reg; dst_l[r32] = dst; if (valid) { v2u t; t.x = __builtin_bit_cast(unsigned, mlog); t.y = __builtin_bit_cast(unsigned, l_reg); *(GAS v2u*)(ML + 2 * (size_t)dst) = t; } }
    asm volatile("s_waitcnt lgkmcnt(0)" ::: "memory");
#pragma unroll
    for (int r = 0; r < 16; ++r) { const int row = crow(r, hi); const float il = __builtin_amdgcn_rcpf(li_l[row]); const int d = dst_l[row];
      if (d >= 0) { v2u w; w.x = cvtpk(o[0][r] * il, o[1][r] * il); w.y = cvtpk(o[2][r] * il, o[3][r] * il); *(GAS v2u*)(OP + (size_t)d * HD + r32 * 4) = w; } }
  }
  asm volatile("s_waitcnt lgkmcnt(0)" ::: "memory");
#undef RESC
#undef KBASE
#undef QREL
}
#undef KSWZ
#undef SBAR
}

__device__ __forceinline__ void top3_insert(float g, int idx, float& v1, float& v2, float& v3, int& i1, int& i2, int& i3) {
    if (g > v1) { v3 = v2; i3 = i2; v2 = v1; i2 = i1; v1 = g; i1 = idx; } else if (g > v2) { v3 = v2; i3 = i2; v2 = g; i2 = idx; } else if (g > v3) { v3 = g; i3 = idx; }
}
__device__ __forceinline__ bool gate_before(float va, int ia, float vb, int ib) { return va > vb || (va == vb && ia < ib); }
#define GSWZ(row, colB) ((row) * 256 + ((colB) ^ (((row) & 7) << 4)))
__device__ __forceinline__ void gate_set(const bf16* __restrict__ proj, int b, int h, int qrow, int own, const char* khi, const char* klo, int r32, int hi,
                                         float& v1, float& v2, float& v3, int& i1, int& i2, int& i3) {
    att::bf16x8 q[8]; att::ld_q(proj, b, h, qrow, hi, q);
    att::f32x16 g = {};
#pragma unroll
    for (int d0 = 0; d0 < 8; ++d0) { const int cb = (d0 * 16 + hi * 8) * 2;
        const att::bf16x8 ah = *reinterpret_cast<const att::bf16x8*>(khi + GSWZ(r32, cb)), al = *reinterpret_cast<const att::bf16x8*>(klo + GSWZ(r32, cb));
        g = __builtin_amdgcn_mfma_f32_32x32x16_bf16(ah, q[d0], g, 0, 0, 0); g = __builtin_amdgcn_mfma_f32_32x32x16_bf16(al, q[d0], g, 0, 0, 0); }
    float w1 = -INFINITY, w2 = -INFINITY, w3 = -INFINITY; int j1 = 0, j2 = 0, j3 = 0;
#pragma unroll
    for (int r = 0; r < 16; ++r) { const int idx = (r & 3) + 8 * (r >> 2) + 4 * hi; const float gv = (idx < own) ? g[r] : -INFINITY;
        const bool b1 = gv > w1, b2 = gv > w2, b3 = gv > w3;
        const float n3 = b2 ? w2 : (b3 ? gv : w3); const int m3 = b2 ? j2 : (b3 ? idx : j3);
        const float n2 = b1 ? w1 : (b2 ? gv : w2); const int m2 = b1 ? j1 : (b2 ? idx : j2);
        const float n1 = b1 ? gv : w1;             const int m1 = b1 ? idx : j1;
        w1 = n1; w2 = n2; w3 = n3; j1 = m1; j2 = m2; j3 = m3; }
    v1 = w1; v2 = w2; v3 = w3; i1 = j1; i2 = j2; i3 = j3;
}
__device__ __forceinline__ void attn_gate_lists(Frame& F, const bool dummy = false) {
    const bf16* proj = WSP(bf16, WS_PROJ); const float* kmean = WSP(float, WS_KMEAN); unsigned* alist = dummy ? WSP(unsigned, WS_Z) : WSP(unsigned, WS_ALIST);
    const int cw_acnt = dummy ? 65536 : CW_ACNT;
    char* khi = (char*)F.ldsg; char* klo = khi + 8192;
    LAS unsigned* ghist = (LAS unsigned*)(F.lds + ATAB_OFF);
    const int lane = F.lane, r32 = lane & 31, hi = lane >> 5;
    for (int it = F.vcu; it < BATCH * NH * (SEQ / 512); it += F.G) {
        const int i2 = it & 15, h = (it >> 4) & 7, b = it >> 7;
        __syncthreads();
        { const int row = F.tid >> 4, c8 = (F.tid & 15) * 8; const GAS f32x4* src = (const GAS f32x4*)(kmean + ((size_t)(b * NH + h) * NBLK + row) * HD + c8); const f32x4 x0 = src[0], x1 = src[1];
          v4u hw, lw; hw.x = pk2(x0.x, x0.y); hw.y = pk2(x0.z, x0.w); hw.z = pk2(x1.x, x1.y); hw.w = pk2(x1.z, x1.w);
          lw.x = pk2(x0.x - bflo(hw.x), x0.y - bfhi(hw.x)); lw.y = pk2(x0.z - bflo(hw.y), x0.w - bfhi(hw.y)); lw.z = pk2(x1.x - bflo(hw.z), x1.y - bfhi(hw.z)); lw.w = pk2(x1.z - bflo(hw.w), x1.w - bfhi(hw.w));
          *(v4u*)(khi + GSWZ(row, c8 * 2)) = hw; *(v4u*)(klo + GSWZ(row, c8 * 2)) = lw; if (F.tid < 32) ghist[F.tid] = 0u; }
        __syncthreads();
        const int qbase = i2 * 512 + F.wave * 64, own = qbase >> 8;
        const int qpos = qbase + lane;
        int s0 = -1, s1i = -1, s2i = -1, off0 = 0, off1 = 0, off2 = 0; unsigned wb = 0;
        if (own > 0) {
            float a1, a2, a3, c1, c2, c3; int ia1, ia2, ia3, ic1, ic2, ic3;
            gate_set(proj, b, h, qbase + r32, own, khi, klo, r32, hi, a1, a2, a3, ia1, ia2, ia3);
            gate_set(proj, b, h, qbase + 32 + r32, own, khi, klo, r32, hi, c1, c2, c3, ic1, ic2, ic3);
            float v1 = hi ? c1 : a1, v2 = hi ? c2 : a2, v3 = hi ? c3 : a3; int i1 = hi ? ic1 : ia1, i2s = hi ? ic2 : ia2, i3 = hi ? ic3 : ia3;
            { const float s1 = hi ? a1 : c1, s2 = hi ? a2 : c2, s3 = hi ? a3 : c3; const int t1 = hi ? ia1 : ic1, t2 = hi ? ia2 : ic2, t3 = hi ? ia3 : ic3;
              const float p1 = __shfl_xor(s1, 32), p2 = __shfl_xor(s2, 32), p3 = __shfl_xor(s3, 32); const int u1 = __shfl_xor(t1, 32), u2 = __shfl_xor(t2, 32), u3 = __shfl_xor(t3, 32);
#define GINS(pv, pi) do { if (gate_before(pv, pi, v1, i1)) { v3 = v2; i3 = i2s; v2 = v1; i2s = i1; v1 = pv; i1 = pi; } else if (gate_before(pv, pi, v2, i2s)) { v3 = v2; i3 = i2s; v2 = pv; i2s = pi; } \
                  else if (gate_before(pv, pi, v3, i3)) { v3 = pv; i3 = pi; } } while (0)
              GINS(p1, u1); GINS(p2, u2); GINS(p3, u3);
#undef GINS
            }
            (void)v1; (void)v2; (void)v3;
            const int nv = own < 3 ? own : 3;
            s0 = i1; s1i = nv > 1 ? i2s : -1; s2i = nv > 2 ? i3 : -1;
            int mycnt = 0;
            const unsigned long long lt = (1ull << lane) - 1ull;
            for (int j = 0; j < own; ++j) {
                const bool mine = (s0 == j) || (s1i == j) || (s2i == j);
                const unsigned long long bal = __ballot(mine);
                const int cw = __popcll(bal), of = __popcll(bal & lt);
                if (lane == j) mycnt = cw;
                if (s0 == j) off0 = of; if (s1i == j) off1 = of; if (s2i == j) off2 = of;
            }
            if (lane < own && mycnt > 0) wb = __hip_atomic_fetch_add(ghist + lane, (unsigned)mycnt, __ATOMIC_RELAXED, __HIP_MEMORY_SCOPE_WORKGROUP);
        }
        __syncthreads();
        if (F.tid < 32) { const unsigned c = ghist[F.tid]; ghist[32 + F.tid] = c ? atomicAdd((unsigned*)(F.ctl + cw_acnt + 16 * ((b * NH + h) * NBLK + F.tid)), c) : 0u; }
        __syncthreads();
        if (own > 0) {
            const unsigned base = ghist[32 + (lane & 31)] + wb;
            const unsigned b0 = (unsigned)__shfl((int)base, s0 < 0 ? 0 : s0), b1 = (unsigned)__shfl((int)base, s1i < 0 ? 0 : s1i), b2 = (unsigned)__shfl((int)base, s2i < 0 ? 0 : s2i);
            unsigned* lb = alist + (size_t)(b * NH + h) * LISTCAP;
            lb[list_base(s0) + b0 + off0] = (unsigned)qpos;
            if (s1i >= 0) lb[list_base(s1i) + b1 + off1] = (unsigned)qpos | (1u << 13);
            if (s2i >= 0) lb[list_base(s2i) + b2 + off2] = (unsigned)qpos | (2u << 13);
        }
    }
#undef GSWZ
}
constexpr int KVCOST = 8;
constexpr int OWNG = 8;
__device__ __forceinline__ void attn_all(Frame& F) {
    const bf16* proj = WSP(bf16, WS_PROJ); const unsigned* alist = WSP(unsigned, WS_ALIST);
    LAS int* pre = (LAS int*)(F.lds + ATAB_OFF);
    __syncthreads();
    { const int t = F.tid; const int n0 = (int)((__hip_atomic_load(F.ctl + CW_ACNT + 16 * (2 * t), RLX_AGENT) + 31u) >> 5), n1 = (int)((__hip_atomic_load(F.ctl + CW_ACNT + 16 * (2 * t + 1), RLX_AGENT) + 31u) >> 5);
      const int c0 = n0 + OWNG + KVCOST, c1 = n1 + OWNG + KVCOST;
      const int s = c0 + c1; int x = s;
#pragma unroll
      for (int o = 1; o < 64; o <<= 1) { const int y = __shfl_up(x, o); if (F.lane >= o) x += y; }
      if (F.lane == 63) pre[1032 + F.wave] = x;
      __syncthreads();
      int woff = 0;
#pragma unroll
      for (int w = 0; w < 8; ++w) woff += (w < F.wave) ? pre[1032 + w] : 0;
      const int excl = woff + x - s;
      pre[2 * t] = excl; pre[2 * t + 1] = excl + c0; if (t == 511) pre[1024] = excl + s; }
    __syncthreads();
    const int CT = pre[1024];
    const int c_lo = (int)(((long)CT * F.vcu) / F.G), c_hi = (int)(((long)CT * (F.vcu + 1)) / F.G);
    int lo = 0, hi = 1023;
    while (lo < hi) { const int mid = (lo + hi + 1) >> 1; if (pre[mid] <= c_lo) lo = mid; else hi = mid - 1; }
    for (int item = lo; item < 1024 && pre[item] < c_hi; ++item) {
        const int ngi = pre[item + 1] - pre[item] - KVCOST;
        int g_lo = c_lo - pre[item] - KVCOST, g_hi = c_hi - pre[item] - KVCOST;
        g_lo = g_lo < 0 ? 0 : g_lo; g_hi = g_hi > ngi ? ngi : g_hi;
        if (g_lo >= g_hi) continue;
        const int j = item & 31, bh = item >> 5, h = bh & 7, b = bh >> 3, nsel = ngi - OWNG;
        const int cnt = (int)__hip_atomic_load(F.ctl + CW_ACNT + 16 * item, RLX_AGENT);
        att::kv_load_block(proj, b, h, j, (char*)F.ldsg);
        const unsigned* lst = alist + (size_t)bh * LISTCAP + list_base(j);
        { const int r32 = F.lane & 31, hi2 = F.lane >> 5;
          for (int gi = g_lo + F.wave; gi < g_hi; gi += NWAVES) {
              if (gi < nsel) {
                  const bool valid = gi * 32 + r32 < cnt; const unsigned e = lst[gi * 32 + (valid ? r32 : 0)]; att::bf16x8 q[8];
                  att::ld_q(proj, b, h, (int)(e & 8191u), hi2, q);
                  att::wave_group<false, 4>(b, h, j, gi, (int)(e & 8191u), (int)(e >> 13), valid, q, (bf16*)F.out, WSP(float, WS_ML), (char*)F.ldsg);
              } else {
                  const int g = gi - nsel, qpos = j * MBLK + g * 32 + r32; att::bf16x8 q[8]; att::ld_q(proj, b, h, qpos, hi2, q);
                  switch (g >> 1) {
                    case 0: att::wave_group<true, 1>(b, h, j, g, qpos, 3, true, q, (bf16*)F.out, WSP(float, WS_ML), (char*)F.ldsg); break;
                    case 1: att::wave_group<true, 2>(b, h, j, g, qpos, 3, true, q, (bf16*)F.out, WSP(float, WS_ML), (char*)F.ldsg); break;
                    case 2: att::wave_group<true, 3>(b, h, j, g, qpos, 3, true, q, (bf16*)F.out, WSP(float, WS_ML), (char*)F.ldsg); break;
                    default: att::wave_group<true, 4>(b, h, j, g, qpos, 3, true, q, (bf16*)F.out, WSP(float, WS_ML), (char*)F.ldsg); break; }
              }
          } }
    }
    __syncthreads();
}

#ifndef STAG16
#define STAG16 0
#endif
#ifndef STAG7
#define STAG7 0
#endif
#ifndef P1_NC
#define P1_NC 128
#define P1_K1 6
#endif
#ifndef MK_N_LAUNCHES
#define MK_N_LAUNCHES 1
#endif
constexpr int NPHASES = 18;
#ifndef PROBE_DUP
#define PROBE_DUP (-1)
#endif

constexpr int N_LAUNCHES = MK_N_LAUNCHES;
struct Args { const float* in[21]; float* out; unsigned char* ws; int ph_lo, ph_hi; };
__global__ void __launch_bounds__(NWAVES * 64, 2) hymba_fwd(Args args) {
    extern __shared__ __attribute__((aligned(16))) unsigned char lds[];
    Frame F;
    F.lds = (LAS unsigned char*)lds; F.ldsg = lds;
    F.MISC = (volatile LAS unsigned*)(F.lds + MISC_OFF);
    F.tid = threadIdx.x; F.lane = F.tid & 63; F.wave = __builtin_amdgcn_readfirstlane(F.tid >> 6);
    F.G = gridDim.x; { const int bx = blockIdx.x; F.vcu = (F.G % 8 == 0) ? (bx % 8) * (F.G / 8) + bx / 8 : bx; }
    F.ws = args.ws; F.ctl = (gu32*)(args.ws + WS_CTL); F.out = args.out;
    F.x = args.in[0]; F.p = args.in[1]; F.g_mix = args.in[2]; F.w_in = args.in[3]; F.beta_attn = args.in[4]; F.w_pool = args.in[5]; F.pool_scale = args.in[6]; F.w_out = args.in[7];
    F.g_ffn = args.in[8]; F.w_rg = args.in[9]; F.b_rg = args.in[10]; F.w_re = args.in[11]; F.b_re = args.in[12]; F.w_eg = args.in[13]; F.w_eu = args.in[14]; F.w_ed = args.in[15];
    F.g_ple = args.in[16]; F.w_ple = args.in[17]; F.w_pg = args.in[18]; F.b_pg = args.in[19]; F.g_final = args.in[20];
    for (int u = F.tid; u < 64; u += NWAVES * 64) ((LAS unsigned*)(F.lds + LDSCTL_OFF))[u] = 0u;
    __syncthreads();
    XcdBarrier bar; bar.bar = (unsigned*)(F.ctl + CW_BAR); bar.x = 0; bar.st = nullptr;
    if (N_LAUNCHES == 1) bar = xcd_barrier_post((unsigned*)(F.ctl + CW_BAR), F.MISC + 8);
#define GRID_BAR() do { if (N_LAUNCHES == 1) xcd_barrier(bar); } while (0)
#define STAGGER(n) do { if (N_LAUNCHES == 1 && (n) > 0) { const int g_ = (cid >> 3) & 3; for (int k_ = 0; k_ < g_ * (n); ++k_) __builtin_amdgcn_s_sleep(127); } } while (0)
    const int lo = args.ph_lo, hi = args.ph_hi;
#define IN(k) (lo <= (k) && (k) < hi)
#define BOTH(k) (IN(k) && IN((k) + 1))
    const int cid = (int)blockIdx.x;

    if (IN(0)) { p0_prologue(F); if (PROBE_DUP == 0) { GRID_BAR(); p0_prologue(F); } if (BOTH(0)) GRID_BAR(); }

    if (IN(1)) {
#define PHASE_GEMM_1 \
        EpiBf16 E{WSP(bf16, WS_PROJ), NIN, 0, WSP(float, WS_RS0)}; \
        { DenseSched S; S.ord.init(T / 256, NIN / 256, F.G, cid); S.A = (const char*)WSP(bf16, WS_XN); S.Bt = (const char*)WSP(bf16, WS_WIN); S.a_tile = (size_t)256 * DM * 2; S.b_tile = (size_t)256 * DM * 2; S.a_pn_off = 0; \
          if (split_) S.ord.lim = K1_ * F.G;                         \
          pg8::gemm_phase<EpiBf16, DenseSched, false>(F.lds + RING_OFF, DM * 2, DM, S, E); } \
        if (split_) { DenseSched S; S.ord.init(T / 256, NIN / 256, F.G - NC_, cid - NC_); S.A = (const char*)WSP(bf16, WS_XN); S.Bt = (const char*)WSP(bf16, WS_WIN); S.a_tile = (size_t)256 * DM * 2; S.b_tile = (size_t)256 * DM * 2; S.a_pn_off = 0; \
          S.ord.L0 = K1_ * F.G;                                      \
          pg8::gemm_phase<EpiBf16, DenseSched, false>(F.lds + RING_OFF, DM * 2, DM, S, E); } \

#define PHASE_BODY_1 \
        constexpr int NC_ = P1_NC, K1_ = P1_K1; \
        const bool split_ = (F.G == 256); const int npart_ = split_ ? NC_ : F.G; \
        if (cid < npart_) conv_experts(F, cid, npart_); \
        __syncthreads(); \
        PHASE_GEMM_1 \

        { PHASE_BODY_1 }
        if (PROBE_DUP == 1) { GRID_BAR(); { PHASE_BODY_1 } }
        if (PROBE_DUP == 101) { GRID_BAR(); { constexpr int NC_ = 128, K1_ = 6; const bool split_ = (F.G == 256); PHASE_GEMM_1 } }
        if (PROBE_DUP == 102) { GRID_BAR(); { constexpr int NC_ = 128; const bool split_ = (F.G == 256); const int npart_ = split_ ? NC_ : F.G; if (cid < npart_) conv_experts(F, cid, npart_); __syncthreads(); } }
        if (BOTH(1)) GRID_BAR();
    }
    if (IN(2)) { p2_kmean_z(F); if (PROBE_DUP == 2) { GRID_BAR(); p2_kmean_z(F); } if (BOTH(2)) GRID_BAR(); }
    if (IN(3)) {
#define PHASE_BODY_3 \
        DenseSched S; S.ord.init(T / 256, NPG, F.G, cid); S.A = (const char*)WSP(bf16, WS_Z); S.Bt = (const char*)WSP(bf16, WS_WPOOL); S.a_tile = (size_t)256 * PW * 2; S.b_tile = (size_t)PG * PG * 2; S.a_pn_off = PG * 2; \
        EpiBf16 E{WSP(bf16, WS_MIX), DM, AW, WSP(float, WS_RS0) + 65536}; \
        pg8::gemm_phase<EpiBf16, DenseSched, false>(F.lds + RING_OFF, PW * 2, PG, S, E); \
        __syncthreads(); \
        attn_gate_lists(F); \

        { PHASE_BODY_3 }
        if (PROBE_DUP == 103) { GRID_BAR(); attn_gate_lists(F, true); }
        if (PROBE_DUP == 104) { GRID_BAR(); { DenseSched S; S.ord.init(T / 256, NPG, F.G, cid); S.A = (const char*)WSP(bf16, WS_Z); S.Bt = (const char*)WSP(bf16, WS_WPOOL); S.a_tile = (size_t)256 * PW * 2; S.b_tile = (size_t)PG * PG * 2; S.a_pn_off = PG * 2; EpiBf16 E{WSP(bf16, WS_MIX), DM, AW, WSP(float, WS_RS0) + 65536}; pg8::gemm_phase<EpiBf16, DenseSched, false>(F.lds + RING_OFF, PW * 2, PG, S, E); } }
        if (BOTH(3)) GRID_BAR();
    }
    if (IN(4)) { attn_all(F); if (PROBE_DUP == 4) { GRID_BAR(); attn_all(F); } if (BOTH(4)) GRID_BAR(); }
    if (IN(6)) { p4_mix_norm(F); if (PROBE_DUP == 6) { GRID_BAR(); p4_mix_norm(F); } if (BOTH(6)) GRID_BAR(); }
    if (IN(7)) {
#define PHASE_BODY_7 \
        DenseSched S; S.ord.init(T / 256, DM / 256, F.G, cid); S.A = (const char*)WSP(bf16, WS_MIX); S.Bt = (const char*)WSP(bf16, WS_WOUT); S.a_tile = (size_t)256 * DM * 2; S.b_tile = (size_t)256 * DM * 2; S.a_pn_off = 0; \
        EpiResBf16 E{WSP(bf16, WS_XN), (bf16*)F.out, DM, WSP(float, WS_SSQ)}; \
        pg8::gemm_phase<EpiResBf16, DenseSched, false>(F.lds + RING_OFF, DM * 2, DM, S, E); \

        STAGGER(STAG7);
        { PHASE_BODY_7 }
        if (PROBE_DUP == 7) { GRID_BAR(); { PHASE_BODY_7 } }
        if (BOTH(7)) GRID_BAR();
    }
    if (IN(9)) {
#define PHASE_BODY_9 \
        DenseSched S; S.ord.init(T / 256, 2, F.G, cid); S.A = (const char*)F.out  ; S.Bt = (const char*)WSP(bf16, WS_WR); S.a_tile = (size_t)256 * DM * 2; S.b_tile = (size_t)(DM / 2) * 2; S.a_pn_off = (size_t)(DM / 2) * 2; \
        EpiLogit E{WSP(float, WS_LOGIT)}; \
        pg8::gemm_phase<EpiLogit, DenseSched, false, GEMM_ALIGN, GEMM_SP2, true>(F.lds + RING_OFF, DM * 2, DM / 2, S, E, DM);        \

        { PHASE_BODY_9 }
        if (PROBE_DUP == 9) { GRID_BAR(); { PHASE_BODY_9 } }
        if (BOTH(9)) GRID_BAR();
    }
    if (IN(10)) { p8_route(F); if (BOTH(10)) GRID_BAR(); }
    if (IN(12)) {
#define PHASE_BODY_12 \
        const int TT = build_tile_table(F); \
        MoeSched S; S.TT = TT; S.NCT = 4; S.G = F.G; S.c = cid; S.tile_e = (const LAS int*)(F.lds + TAB_OFF); S.A = (const char*)F.out  ; S.Bt = (const char*)WSP(bf16, WS_WGU); \
        S.b_exp = (size_t)1024 * DM * 2; S.b_ct = (size_t)256 * DM * 2; S.a_tile = 0; S.elist = (const int*)(F.ws + WS_ROUTE + RT_ELIST); S.a_row = DM * 2; \
        EpiGU E{WSP(bf16, WS_MIX), WSP(float, WS_ERS)}; \
        pg8::gemm_phase<EpiGU, MoeSched, true>(F.lds + RING_OFF, 0u, DM, S, E); \

        { PHASE_BODY_12 }
        if (PROBE_DUP == 12) { GRID_BAR(); { PHASE_BODY_12 } }
        if (BOTH(12)) GRID_BAR();
    }
    if (IN(13)) {
#define PHASE_BODY_13 \
        const int TT = (N_LAUNCHES == 1) ? ((const LAS int*)(F.lds + TAB_OFF))[MAXTILES + 64] : build_tile_table(F);        \
        MoeSched S; S.TT = TT; S.NCT = 8; S.G = F.G; S.c = cid; S.tile_e = (const LAS int*)(F.lds + TAB_OFF); S.A = (const char*)WSP(bf16, WS_MIX); S.Bt = (const char*)WSP(bf16, WS_WD); \
        S.b_exp = (size_t)DM * DE * 2; S.b_ct = (size_t)256 * DE * 2; S.a_tile = (size_t)256 * DE * 2; S.elist = (const int*)(F.ws + WS_ROUTE + RT_ELIST); S.a_row = 0; \
        EpiDown E{WSP(bf16, WS_PROJ), (const int*)(F.ws + WS_ROUTE + RT_ELIST), (const float*)(F.ws + WS_ROUTE + RT_EWL), WSP(bf16, WS_Z)};        \
        pg8::gemm_phase<EpiDown, MoeSched, false>(F.lds + RING_OFF, DE * 2, DE, S, E); \

        { PHASE_BODY_13 }
        if (PROBE_DUP == 13) { GRID_BAR(); { PHASE_BODY_13 } }
        if (BOTH(13)) GRID_BAR();
    }
    if (IN(14)) { p12_combine(F); __syncthreads(); }
    if (IN(15)) {
#define PHASE_BODY_15 \
        DenseSched S; S.ord.init(T / 256, DM / 256, F.G, cid); S.A = (const char*)WSP(bf16, WS_PBF); S.Bt = (const char*)WSP(bf16, WS_WPLE); S.a_tile = (size_t)256 * PLE * 2; S.b_tile = (size_t)256 * PLE * 2; S.a_pn_off = 0; \
        EpiBf16 E{WSP(bf16, WS_MIX), DM, 0, WSP(float, WS_RS0) + 65536}; \
        pg8::gemm_phase<EpiBf16, DenseSched, false>(F.lds + RING_OFF, PLE * 2, PLE, S, E); \

        { PHASE_BODY_15 }
        if (PROBE_DUP == 15) { GRID_BAR(); { PHASE_BODY_15 } }
        if (BOTH(15)) GRID_BAR();
    }
    if (IN(16)) {
        STAGGER(STAG16);
#define PHASE_BODY_16 \
        DenseSched S; S.ord.init(T / 256, DM / 256, F.G, cid); S.A = (const char*)F.out  ; S.Bt = (const char*)WSP(bf16, WS_WPG); S.a_tile = (size_t)256 * DM * 2; S.b_tile = (size_t)256 * DM * 2; S.a_pn_off = 0; \
        EpiPle E{(const bf16*)F.out, WSP(bf16, WS_PROJ), WSP(bf16, WS_MIX), F.b_pg, WSP(float, WS_RS3)}; \
        pg8::gemm_phase<EpiPle, DenseSched, false>(F.lds + RING_OFF, DM * 2, DM, S, E); \

        { PHASE_BODY_16 }
        if (PROBE_DUP == 16) { GRID_BAR(); { PHASE_BODY_16 } }
        if (BOTH(16)) GRID_BAR();
    }
    if (IN(17)) { p15_final(F); if (PROBE_DUP == 17) { GRID_BAR(); p15_final(F); } }
#undef IN
#undef BOTH
}

extern "C" void kernel_launch(void* const* d_in, const int* in_sizes, int n_in, void* d_out, int out_size, void* d_ws, size_t ws_size, hipStream_t stream) {
    static int grid = 0;
    if (grid == 0) {
        if (n_in != 21 || in_sizes[0] != T * DM || out_size != T * DM || ws_size < WS_END2) { fprintf(stderr, "kernel_launch: shape mismatch n_in %d in0 %d out %d ws %zu (need %zu)\n", n_in, n_in > 0 ? in_sizes[0] : -1, out_size, ws_size, (size_t)WS_END2); grid = -1; return; }
        int dev = 0, cus = 0, per_cu = 0;
        if (hipGetDevice(&dev) != hipSuccess || hipDeviceGetAttribute(&cus, hipDeviceAttributeMultiprocessorCount, dev) != hipSuccess) { grid = -1; return; }
        if (hipFuncSetAttribute((const void*)hymba_fwd, hipFuncAttributeMaxDynamicSharedMemorySize, LDS_BYTES) != hipSuccess) { fprintf(stderr, "kernel_launch: hipFuncSetAttribute failed\n"); grid = -1; return; }
        if (hipOccupancyMaxActiveBlocksPerMultiprocessor(&per_cu, (const void*)hymba_fwd, NWAVES * 64, LDS_BYTES) != hipSuccess || per_cu < 1) { fprintf(stderr, "kernel_launch: occupancy query says %d\n", per_cu); }
        (void)hipGetLastError();
        grid = cus;
    }
    if (grid < 0) return;
    (void)hipMemsetAsync((char*)d_ws + WS_CTL, 0, CTL_ZERO_BYTES, stream);
    Args a{};
    for (int i = 0; i < 21; ++i) a.in[i] = (const float*)d_in[i];
    a.out = (float*)d_out; a.ws = (unsigned char*)d_ws;
    if (N_LAUNCHES == 1) { a.ph_lo = 0; a.ph_hi = NPHASES; hipLaunchKernelGGL(hymba_fwd, dim3(grid), dim3(NWAVES * 64), LDS_BYTES, stream, a); }
    else { for (int li = 0; li < NPHASES; ++li) { a.ph_lo = li; a.ph_hi = li + 1; hipLaunchKernelGGL(hymba_fwd, dim3(grid), dim3(NWAVES * 64), LDS_BYTES, stream, a); } }
    const hipError_t le = hipPeekAtLastError();
    if (le != hipSuccess) fprintf(stderr, "kernel_launch: launch failed: %s\n", hipGetErrorName(le));
}
```
